# Optimizing an MI355X kernel written in HIP

```python
import math
import jax, jax.numpy as jnp
from jax import lax
import numpy as np

D_MODEL = 1024
BATCH = 16
SEQ = 4096
DEPTH = 4
DEC_BATCH = 4
DEC_SEQ = 8192
PAST_LEN = 128

N_HEADS = 8
N_KV_HEADS = 2
HEAD_DIM = 64
ATT_WIDTH = N_HEADS * HEAD_DIM
KV_WIDTH = N_KV_HEADS * HEAD_DIM
WINDOW = 128
BLOCK = 128
ROPE_DIM = HEAD_DIM // 4
ROPE_THETA = 500000.0
F_GROUPS = 4
F_GROUP_DIM = 128
F_WIDTH = F_GROUPS * F_GROUP_DIM
PLE_DIM = 256
EPS = 1e-6

SPLITS = [ATT_WIDTH, KV_WIDTH, KV_WIDTH, ATT_WIDTH, F_WIDTH, F_WIDTH, D_MODEL, D_MODEL]
IN_WIDTH = sum(SPLITS)
SPLIT_IDX = list(np.cumsum(SPLITS)[:-1])

kernel_name = "hybrid_window_gqa_fnet_gated_encoder"


def rmsnorm(x, g):
    xf = x.astype(jnp.float32)
    y = xf * lax.rsqrt(jnp.mean(xf * xf, axis=-1, keepdims=True) + EPS)
    return (y * g.astype(jnp.float32)).astype(x.dtype)


def partial_rope(x, pos):
    half = ROPE_DIM // 2
    inv_freq = ROPE_THETA ** (-jnp.arange(0, ROPE_DIM, 2, dtype=jnp.float32) / ROPE_DIM)
    ang = pos.astype(jnp.float32)[:, None] * inv_freq[None, :]
    cos = jnp.cos(ang)[None, :, None, :].astype(x.dtype)
    sin = jnp.sin(ang)[None, :, None, :].astype(x.dtype)
    x1 = x[..., :half]
    x2 = x[..., half:ROPE_DIM]
    return jnp.concatenate([x1 * cos - x2 * sin, x2 * cos + x1 * sin, x[..., ROPE_DIM:]], axis=-1)


def band_attention(q, k, v, sink):
    B, S = q.shape[0], q.shape[1]
    nb = S // BLOCK
    R = N_HEADS // N_KV_HEADS
    qb = q.reshape(B, nb, BLOCK, N_KV_HEADS, R, HEAD_DIM)
    pad = ((0, 0), (BLOCK, BLOCK), (0, 0), (0, 0))
    kp = jnp.pad(k, pad).reshape(B, nb + 2, BLOCK, N_KV_HEADS, HEAD_DIM)
    vp = jnp.pad(v, pad).reshape(B, nb + 2, BLOCK, N_KV_HEADS, HEAD_DIM)
    kw = jnp.concatenate([kp[:, :-2], kp[:, 1:-1], kp[:, 2:]], axis=2)
    vw = jnp.concatenate([vp[:, :-2], vp[:, 1:-1], vp[:, 2:]], axis=2)
    s = jnp.einsum('bnqgrd,bnkgd->bngrqk', qb, kw).astype(jnp.float32) * (1.0 / math.sqrt(HEAD_DIM))
    qi = jnp.arange(BLOCK)[:, None]
    ki = jnp.arange(3 * BLOCK)[None, :]
    rel = ki - BLOCK - qi
    jpos = jnp.arange(nb)[:, None, None] * BLOCK + (ki - BLOCK)[None]
    valid = (jnp.abs(rel)[None] <= WINDOW) & (jpos >= 0) & (jpos < S)
    s = jnp.where(valid[None, :, None, None], s, -1e30)
    sk = sink.astype(jnp.float32).reshape(N_KV_HEADS, R)[None, None, :, :, None, None]
    m = jnp.maximum(jnp.max(s, axis=-1, keepdims=True), sk)
    e = jnp.exp(s - m)
    pr = (e / (jnp.sum(e, axis=-1, keepdims=True) + jnp.exp(sk - m))).astype(v.dtype)
    o = jnp.einsum('bngrqk,bnkgd->bnqgrd', pr, vw)
    return o.reshape(B, S, ATT_WIDTH)


def fourier_mix(u, w_fmix):
    B, S = u.shape[0], u.shape[1]
    ug = u.reshape(B, S, F_GROUPS, F_GROUP_DIM).astype(jnp.float32)
    f = jnp.real(jnp.fft.fft2(ug, axes=(1, 3), norm='ortho')).astype(u.dtype)
    y = jnp.einsum('bsgc,gcd->bsgd', f, w_fmix)
    return y.reshape(B, S, F_WIDTH)


def trunk(x, p, ln1, w_in, sink, w_fmix, w_ao, w_fo, w_out, w_pe, ln_pg, w_pg, ln_f):
    B, S, _ = x.shape
    pos = jnp.arange(S)
    h = x
    for i in range(DEPTH):
        hn = rmsnorm(h, ln1[i])
        z = hn @ w_in[i]
        q, k, v, ga, uf, gf, mga, mgf = jnp.split(z, SPLIT_IDX, axis=-1)
        q = partial_rope(q.reshape(B, S, N_HEADS, HEAD_DIM), pos)
        k = partial_rope(k.reshape(B, S, N_KV_HEADS, HEAD_DIM), pos)
        v = v.reshape(B, S, N_KV_HEADS, HEAD_DIM)
        a = band_attention(q, k, v, sink[i]) * jax.nn.silu(ga)
        f = fourier_mix(uf, w_fmix[i]) * jax.nn.silu(gf)
        merged = jax.nn.sigmoid(mga) * (a @ w_ao[i]) + jax.nn.sigmoid(mgf) * (f @ w_fo[i])
        h = h + merged @ w_out[i]
        gate = jax.nn.sigmoid(rmsnorm(h, ln_pg[i]) @ w_pg[i])
        h = h + (p[i].astype(h.dtype) @ w_pe[i]) * gate
    return rmsnorm(h, ln_f)


def setup_inputs(seed: int = 0) -> dict:
    key = jax.random.key(seed)
    ks = jax.random.split(key, 16)
    f32 = jnp.float32
    nrm = lambda k, shape, scale: jax.random.normal(k, shape, f32) * scale
    return {
        "x_prompt": nrm(ks[0], (BATCH, SEQ, D_MODEL), 1.0),
        "x_sample": nrm(ks[1], (DEC_BATCH, DEC_SEQ, D_MODEL), 1.0),
        "p_prompt": nrm(ks[2], (DEPTH, BATCH, SEQ, PLE_DIM), 1.0),
        "p_sample": nrm(ks[3], (DEPTH, DEC_BATCH, DEC_SEQ, PLE_DIM), 1.0),
        "ln1": 1.0 + nrm(ks[4], (DEPTH, D_MODEL), 0.01),
        "w_in": nrm(ks[5], (DEPTH, D_MODEL, IN_WIDTH), D_MODEL ** -0.5),
        "sink": nrm(ks[6], (DEPTH, N_HEADS), 0.5),
        "w_fmix": nrm(ks[7], (DEPTH, F_GROUPS, F_GROUP_DIM, F_GROUP_DIM), F_GROUP_DIM ** -0.5),
        "w_ao": nrm(ks[8], (DEPTH, ATT_WIDTH, D_MODEL), ATT_WIDTH ** -0.5),
        "w_fo": nrm(ks[9], (DEPTH, F_WIDTH, D_MODEL), F_WIDTH ** -0.5),
        "w_out": nrm(ks[10], (DEPTH, D_MODEL, D_MODEL), 0.5 * D_MODEL ** -0.5),
        "w_pe": nrm(ks[11], (DEPTH, PLE_DIM, D_MODEL), 0.5 * PLE_DIM ** -0.5),
        "ln_pg": 1.0 + nrm(ks[12], (DEPTH, D_MODEL), 0.01),
        "w_pg": nrm(ks[13], (DEPTH, D_MODEL, D_MODEL), D_MODEL ** -0.5),
        "ln_f": 1.0 + nrm(ks[14], (D_MODEL,), 0.01),
    }


def reference(x_prompt, x_sample, p_prompt, p_sample, ln1, w_in, sink, w_fmix, w_ao, w_fo,
              w_out, w_pe, ln_pg, w_pg, ln_f):
    y_prompt = trunk(x_prompt, p_prompt, ln1, w_in, sink, w_fmix, w_ao, w_fo, w_out, w_pe, ln_pg, w_pg, ln_f)
    y_sample = trunk(x_sample, p_sample, ln1, w_in, sink, w_fmix, w_ao, w_fo, w_out, w_pe, ln_pg, w_pg, ln_f)
    return (y_prompt, y_sample)
```

```cpp
#include <hip/hip_runtime.h>
#include <hip/hip_cooperative_groups.h>
#include <cstdio>
#include <cstdint>
namespace cg = cooperative_groups;

#define LAS __attribute__((address_space(3)))
typedef _Float16 h16;
typedef _Float16 h16x8 __attribute__((ext_vector_type(8)));
typedef _Float16 h16x4 __attribute__((ext_vector_type(4)));
typedef _Float16 h16x2 __attribute__((ext_vector_type(2)));
typedef float f32x4 __attribute__((ext_vector_type(4)));
typedef float f32x2 __attribute__((ext_vector_type(2)));
typedef float f32x16 __attribute__((ext_vector_type(16)));
typedef short v4i16_t __attribute__((ext_vector_type(4)));

constexpr int DM = 1024, DEPTH = 4, ZW = 4352, PLE = 256;
constexpr int C_Q = 0, C_K = 512, C_V = 640, C_GA = 768, C_UF = 1280, C_GF = 1792, C_MGA = 2304, C_MGF = 3328;
constexpr int MG_MAX = 65536;
constexpr float EPS = 1e-6f;
constexpr size_t LW_IN = 0, LW_AO = LW_IN + (size_t)ZW * DM, LW_FO = LW_AO + (size_t)DM * 512, LW_OUT = LW_FO + (size_t)DM * 512,
                 LW_PG = LW_OUT + (size_t)DM * DM, LW_PE = LW_PG + (size_t)DM * DM, LW_FM = LW_PE + (size_t)DM * PLE, LW_SZ = LW_FM + 4 * 128 * 128;
constexpr size_t WS_Z = 0;
constexpr size_t WS_G = WS_Z + (size_t)MG_MAX * ZW * 2;
constexpr size_t WS_HA = WS_G + (size_t)MG_MAX * 2048;
constexpr size_t WS_P16 = WS_HA + (size_t)MG_MAX * 2048;
constexpr size_t WS_PART1 = WS_P16 + (size_t)MG_MAX * 512;
constexpr size_t WS_PART2 = WS_PART1 + (size_t)MG_MAX * 64;
constexpr size_t WS_W = WS_PART2 + (size_t)MG_MAX * 64;
constexpr size_t WS_ROPE = WS_W + (size_t)DEPTH * LW_SZ * 2;
constexpr size_t WS_T1A = WS_ROPE + 8192 * 8 * 8;
constexpr size_t WS_T1B64 = WS_T1A + 256 * 128 * 2;
constexpr size_t WS_T1B128 = WS_T1B64 + 128 * 128 * 2;
constexpr size_t WS_T2 = WS_T1B128 + 256 * 256 * 2;
constexpr size_t WS_TW64 = WS_T2 + 64 * 128 * 2;
constexpr size_t WS_TW128 = WS_TW64 + 64 * 64 * 8;
constexpr size_t WS_END = WS_TW128 + 128 * 64 * 8;

constexpr int LDS_BYTES = 139264;

__device__ __forceinline__ float sigm(float x) { return __builtin_amdgcn_rcpf(1.0f + __builtin_amdgcn_exp2f(-1.44269504089f * x)); }

namespace pg8 {
constexpr int BM = 256, BK = 64, HALF = 128, HTB = HALF * BK * 2, NXCD = 8, WGM = 8;
__device__ __forceinline__ int lds_byte(int r, int c) { const int st = (r >> 4) * 2 + (c >> 5), rr = r & 15, cc = c & 31, ob = rr * 64 + cc * 2; return st * 1024 + (ob ^ (((ob >> 9) & 1) << 5)); }
__device__ __forceinline__ void stage_rc(int b, int& R, int& C) { const int st = b / 1024, sb = b % 1024, swz = sb ^ (((sb >> 9) & 1) << 5); R = (st >> 1) * 16 + swz / 64; C = (st & 1) * 32 + (swz % 64) / 2; }
__device__ __forceinline__ int perm32(int rho) { const int n = rho >> 4, i = rho & 15; return 8 * (i >> 2) + 4 * n + (i & 3); }
struct Unit { int pm, pn; };
struct Gemm { const h16* A; int lda; const h16* Bt; int M, N, K; };
struct StaticOrder {
    int nM, nN, nwg, G, c;
    __device__ void init(int M, int N, int G_, int c_) { nM = M / BM; nN = N / BM; nwg = nM * nN; G = G_; c = c_; }
    __device__ bool next(int i, Unit& u) const {
        const long L = (long)i * G + c; if (L >= nwg) return false;
        int wgid = (int)L; { const int q = nwg / NXCD, r = nwg % NXCD, xcd = wgid % NXCD, off = wgid / NXCD; wgid = (xcd < r ? xcd * (q + 1) : r * (q + 1) + (xcd - r) * q) + off; }
        const int nig = WGM * nN, gid = wgid / nig, fm = gid * WGM, gsz = (nM - fm) < WGM ? (nM - fm) : WGM;
        u.pm = fm + ((wgid % nig) % gsz); u.pn = (wgid % nig) / gsz; return true;
    }
};
typedef f32x4 Acc[2][2][4][2];

template <class Epi>
__device__ __forceinline__ void gemm_phase(LAS unsigned char* lds, const Gemm g, const StaticOrder& S, const Epi& E) {
    int tid_ = threadIdx.x; asm volatile("" : "+v"(tid_));
    const int tid = tid_, wid = __builtin_amdgcn_readfirstlane(tid >> 6), lane = tid & 63, wr = wid >> 2, wc = wid & 3, fr = lane & 15, fq = lane >> 4;
    const int K = g.K, nt = K / BK;
    unsigned voffA[2], voffB[2];
#pragma unroll
    for (int i = 0; i < 2; ++i) { int R, C; stage_rc(tid * 16 + i * 8192, R, C); const int Rb = (R & ~31) + perm32(R & 31);
        voffA[i] = (unsigned)(R * g.lda + C) * 2u; voffB[i] = (unsigned)(Rb * K + C) * 2u; }
    const size_t kstep = (size_t)(BK * 2);
    const size_t hstepA = (size_t)HALF * g.lda * 2, tstepA = 2 * hstepA;
    const size_t hstepB = (size_t)HALF * K * 2, tstepB = 2 * hstepB;
    const unsigned ldsw = (unsigned)wid * 1024u;
    const int aoff = lds_byte(wr * 64 + fr, fq * 8), boff = lds_byte(wc * 32 + fr, fq * 8);
#define PG8_SA(b, h) (((b) * 2 + (h)) * HTB)
#define PG8_SB(b, h) ((4 + (b) * 2 + (h)) * HTB)
#define PG8_STAGE(bufoff, gbase, voff) do { _Pragma("unroll") for (int _i = 0; _i < 2; ++_i) \
        __builtin_amdgcn_global_load_lds((const unsigned*)((const char*)(gbase) + (voff)[_i]), (LAS unsigned*)(lds + (bufoff) + ldsw + _i * 8192), 16, 0, 0); } while (0)
#define PG8_LDA(dst, b, h) do { _Pragma("unroll") for (int m = 0; m < 4; ++m) _Pragma("unroll") for (int k = 0; k < 2; ++k) dst[m][k] = *(const LAS h16x8*)(lds + PG8_SA(b, h) + aoff + m * 2048 + k * 1024); } while (0)
#define PG8_LDB(dst, b, h) do { _Pragma("unroll") for (int n = 0; n < 2; ++n) _Pragma("unroll") for (int k = 0; k < 2; ++k) dst[n][k] = *(const LAS h16x8*)(lds + PG8_SB(b, h) + boff + n * 2048 + k * 1024); } while (0)
#define PG8_MMA(ai, bj, At, Bt) do { __builtin_amdgcn_s_setprio(1); _Pragma("unroll") for (int m = 0; m < 4; ++m) _Pragma("unroll") for (int n = 0; n < 2; ++n) _Pragma("unroll") for (int k = 0; k < 2; ++k) \
        acc[ai][bj][m][n] = __builtin_amdgcn_mfma_f32_16x16x32_f16(Bt[n][k], At[m][k], acc[ai][bj][m][n], 0, 0, 0); __builtin_amdgcn_s_setprio(0); } while (0)
#define PG8_WAIT_V(n) asm volatile("s_waitcnt vmcnt(" #n ")" ::: "memory")
#define PG8_WAIT_L(n) asm volatile("s_waitcnt lgkmcnt(" #n ")" ::: "memory")
#define PG8_BAR __builtin_amdgcn_s_barrier()
#define PG8_SCHED __builtin_amdgcn_sched_barrier(0)
    Unit cur, nxt; int ui = 0;
    if (!S.next(0, cur)) return;
    Acc acc;
#pragma unroll
    for (int a = 0; a < 2; ++a)
#pragma unroll
        for (int b = 0; b < 2; ++b)
#pragma unroll
            for (int m = 0; m < 4; ++m)
#pragma unroll
                for (int n = 0; n < 2; ++n) acc[a][b][m][n] = (f32x4){0.f, 0.f, 0.f, 0.f};
    h16x8 At[4][2], B0[2][2], B1[2][2];
    const char* cA = (const char*)g.A + (size_t)cur.pm * tstepA; const char* cB = (const char*)g.Bt + (size_t)cur.pn * tstepB;
    PG8_STAGE(PG8_SB(0, 0), cB, voffB); PG8_STAGE(PG8_SB(0, 1), cB + hstepB, voffB); PG8_STAGE(PG8_SA(0, 0), cA, voffA); PG8_STAGE(PG8_SA(0, 1), cA + hstepA, voffA);
    if (wr == 1) PG8_BAR;
    PG8_WAIT_V(2); PG8_BAR;
    PG8_STAGE(PG8_SB(1, 0), cB + kstep, voffB); PG8_STAGE(PG8_SA(1, 0), cA + kstep, voffA); PG8_STAGE(PG8_SB(1, 1), cB + hstepB + kstep, voffB);
    PG8_WAIT_V(6); PG8_BAR;
    for (;;) {
        const bool has_next = S.next(ui + 1, nxt);
        const char* nA = has_next ? (const char*)g.A + (size_t)nxt.pm * tstepA : cA; const char* nB = has_next ? (const char*)g.Bt + (size_t)nxt.pn * tstepB : cB;
        for (int t = 0; t < nt; t += 2) {
            const bool last = (t == nt - 2);
            const char* a1 = cA + (size_t)(t + 1) * kstep;
            const char* a2 = last ? nA : cA + (size_t)(t + 2) * kstep; const char* b2 = last ? nB : cB + (size_t)(t + 2) * kstep;
            const char* a3 = a2 + kstep; const char* b3 = b2 + kstep;
            PG8_LDB(B0, 0, 0); PG8_LDB(B1, 0, 1); PG8_SCHED; PG8_LDA(At, 0, 0); PG8_STAGE(PG8_SA(1, 1), a1 + hstepA, voffA);
            PG8_WAIT_V(8); PG8_WAIT_L(0); PG8_BAR; PG8_MMA(0, 0, At, B0); PG8_MMA(0, 1, At, B1); PG8_BAR; PG8_SCHED;
            PG8_LDA(At, 0, 1); PG8_STAGE(PG8_SB(0, 0), b2, voffB); PG8_STAGE(PG8_SB(0, 1), b2 + hstepB, voffB); PG8_STAGE(PG8_SA(0, 0), a2, voffA);
            PG8_WAIT_V(8); PG8_WAIT_L(0); PG8_BAR; PG8_MMA(1, 0, At, B0); PG8_MMA(1, 1, At, B1); PG8_BAR; PG8_SCHED;
            PG8_LDB(B0, 1, 0); PG8_LDB(B1, 1, 1); PG8_SCHED; PG8_LDA(At, 1, 0); PG8_STAGE(PG8_SA(0, 1), a2 + hstepA, voffA);
            PG8_WAIT_V(8); PG8_WAIT_L(0); PG8_BAR; PG8_MMA(0, 0, At, B0); PG8_MMA(0, 1, At, B1); PG8_BAR; PG8_SCHED;
            PG8_LDA(At, 1, 1); PG8_STAGE(PG8_SB(1, 0), b3, voffB); PG8_STAGE(PG8_SB(1, 1), b3 + hstepB, voffB); PG8_STAGE(PG8_SA(1, 0), a3, voffA);
            PG8_WAIT_V(8); PG8_WAIT_L(0); PG8_BAR; PG8_MMA(1, 0, At, B0); PG8_MMA(1, 1, At, B1); PG8_BAR; PG8_SCHED;
        }
        if (wr == 0) PG8_BAR;
        { int t2 = threadIdx.x; asm volatile("" : "+v"(t2)); const int w2 = __builtin_amdgcn_readfirstlane(t2 >> 6), l2 = t2 & 63; E(acc, cur, w2 >> 2, w2 & 3, l2 & 15, l2 >> 4); }
        if (!has_next) break;
#pragma unroll
        for (int a = 0; a < 2; ++a)
#pragma unroll
            for (int b = 0; b < 2; ++b)
#pragma unroll
                for (int m = 0; m < 4; ++m)
#pragma unroll
                    for (int n = 0; n < 2; ++n) acc[a][b][m][n] = (f32x4){0.f, 0.f, 0.f, 0.f};
        cur = nxt; cA = nA; cB = nB; ++ui;
        if (wr == 1) PG8_BAR;
    }
    PG8_WAIT_V(0);
    PG8_BAR;
#undef PG8_SA
#undef PG8_SB
#undef PG8_STAGE
#undef PG8_LDA
#undef PG8_LDB
#undef PG8_MMA
#undef PG8_WAIT_V
#undef PG8_WAIT_L
#undef PG8_BAR
#undef PG8_SCHED
}

#define EPI_ROWS(...) _Pragma("unroll") for (int ai = 0; ai < 2; ++ai) _Pragma("unroll") for (int m = 0; m < 4; ++m) { const int r = u.pm * BM + ai * HALF + wr * 64 + m * 16 + fr; __VA_ARGS__ asm volatile("" ::: "memory"); }
#define EPI_COLS(...) _Pragma("unroll") for (int bj = 0; bj < 2; ++bj) { const int c = u.pn * BM + bj * HALF + wc * 32 + 8 * fq; const f32x4 v0 = acc[ai][bj][m][0], v1 = acc[ai][bj][m][1]; __VA_ARGS__ }
__device__ __forceinline__ float rstd_from(const float* part, int r) {
    const f32x4* pp = (const f32x4*)(part + (size_t)r * 16); const f32x4 a = pp[0], b = pp[1], c = pp[2], d = pp[3];
    const float ss = ((a[0] + a[1]) + (a[2] + a[3])) + ((b[0] + b[1]) + (b[2] + b[3])) + ((c[0] + c[1]) + (c[2] + c[3])) + ((d[0] + d[1]) + (d[2] + d[3]));
    return __builtin_amdgcn_rsqf(ss * (1.0f / 1024.0f) + EPS);
}
__device__ __forceinline__ h16x8 pack8(f32x4 a, f32x4 b) { h16x8 o; o[0] = (h16)a[0]; o[1] = (h16)a[1]; o[2] = (h16)a[2]; o[3] = (h16)a[3]; o[4] = (h16)b[0]; o[5] = (h16)b[1]; o[6] = (h16)b[2]; o[7] = (h16)b[3]; return o; }
struct EpiZ { h16* z; const float* part;
    __device__ __forceinline__ void operator()(const Acc& acc, const Unit& u, int wr, int wc, int fr, int fq) const {
        EPI_ROWS( const float rs = rstd_from(part, r); EPI_COLS( *(h16x8*)(z + (size_t)r * ZW + c) = pack8(v0 * rs, v1 * rs); ) )
    } };
struct EpiD1 { h16* z;
    __device__ __forceinline__ void operator()(const Acc& acc, const Unit& u, int wr, int wc, int fr, int fq) const {
        EPI_ROWS( EPI_COLS( h16x8* p = (h16x8*)(z + (size_t)r * ZW + C_MGA + c); const h16x8 gte = *p; h16x8 o;
            _Pragma("unroll") for (int i = 0; i < 4; ++i) { o[i] = (h16)(v0[i] * sigm((float)gte[i])); o[4 + i] = (h16)(v1[i] * sigm((float)gte[4 + i])); } *p = o; ) )
    } };
struct EpiD2 { h16* z;
    __device__ __forceinline__ void operator()(const Acc& acc, const Unit& u, int wr, int wc, int fr, int fq) const {
        EPI_ROWS( EPI_COLS( h16x8* p = (h16x8*)(z + (size_t)r * ZW + C_MGA + c); const h16x8 t1 = *p; const h16x8 gte = *(const h16x8*)(z + (size_t)r * ZW + C_MGF + c); h16x8 o;
            _Pragma("unroll") for (int i = 0; i < 4; ++i) { o[i] = (h16)((float)t1[i] + v0[i] * sigm((float)gte[i])); o[4 + i] = (h16)((float)t1[4 + i] + v1[i] * sigm((float)gte[4 + i])); } *p = o; ) )
    } };
struct EpiE { const float* hsrc; float* out; h16* z; float* part;
    __device__ __forceinline__ void operator()(const Acc& acc, const Unit& u, int wr, int wc, int fr, int fq) const {
        EPI_ROWS( float ss = 0.f;
            EPI_COLS( const f32x4* hp = (const f32x4*)(hsrc + (size_t)r * DM + c); const f32x4 a = hp[0] + v0, b = hp[1] + v1; f32x4* op = (f32x4*)(out + (size_t)r * DM + c); op[0] = a; op[1] = b;
                *(h16x8*)(z + (size_t)r * ZW + C_MGF + c) = pack8(a, b); ss += (a[0] * a[0] + a[1] * a[1]) + (a[2] * a[2] + a[3] * a[3]) + (b[0] * b[0] + b[1] * b[1]) + (b[2] * b[2] + b[3] * b[3]); )
            ss += __shfl_xor(ss, 16); ss += __shfl_xor(ss, 32); if (fq == 0) part[(size_t)r * 16 + u.pn * 4 + wc] = ss; )
    } };
struct EpiF1 { h16* z; const float* part;
    __device__ __forceinline__ void operator()(const Acc& acc, const Unit& u, int wr, int wc, int fr, int fq) const {
        EPI_ROWS( const float rs = rstd_from(part, r); EPI_COLS( h16x8 o;
            _Pragma("unroll") for (int i = 0; i < 4; ++i) { o[i] = (h16)sigm(v0[i] * rs); o[4 + i] = (h16)sigm(v1[i] * rs); } *(h16x8*)(z + (size_t)r * ZW + C_MGA + c) = o; ) )
    } };
struct EpiF2 { float* out; const h16* z; h16* ha; float* part;
    __device__ __forceinline__ void operator()(const Acc& acc, const Unit& u, int wr, int wc, int fr, int fq) const {
        EPI_ROWS( float ss = 0.f;
            EPI_COLS( const h16x8 gt = *(const h16x8*)(z + (size_t)r * ZW + C_MGA + c); f32x4* op = (f32x4*)(out + (size_t)r * DM + c); f32x4 a = op[0], b = op[1];
                _Pragma("unroll") for (int i = 0; i < 4; ++i) { a[i] += v0[i] * (float)gt[i]; b[i] += v1[i] * (float)gt[4 + i]; } op[0] = a; op[1] = b;
                *(h16x8*)(ha + (size_t)r * DM + c) = pack8(a, b); ss += (a[0] * a[0] + a[1] * a[1]) + (a[2] * a[2] + a[3] * a[3]) + (b[0] * b[0] + b[1] * b[1]) + (b[2] * b[2] + b[3] * b[3]); )
            ss += __shfl_xor(ss, 16); ss += __shfl_xor(ss, 32); if (fq == 0) part[(size_t)r * 16 + u.pn * 4 + wc] = ss; )
    } };
}

struct Args { const float* in[15]; float* out; unsigned char* ws; int step_lo, step_hi; };
struct Grp { int B, S, M, N1; const float* x; const float* p; float* out; size_t p_lstride; };

__device__ __forceinline__ h16x8 ld8(const h16* p) { return *(const h16x8*)p; }
__device__ __forceinline__ h16x4 ld4(const h16* p) { return *(const h16x4*)p; }
__device__ __forceinline__ h16x4 tr4(const LAS unsigned char* p) { return __builtin_bit_cast(h16x4, __builtin_amdgcn_ds_read_tr16_b64_v4i16((LAS v4i16_t*)p)); }
__device__ __forceinline__ h16x8 cat8(h16x4 a, h16x4 b) { return (h16x8){a[0], a[1], a[2], a[3], b[0], b[1], b[2], b[3]}; }
__device__ __forceinline__ h16x8 pack_lo(const f32x16& v) { h16x8 o; _Pragma("unroll") for (int i = 0; i < 8; ++i) o[i] = (h16)v[i]; return o; }
__device__ __forceinline__ h16x8 pack_hi(const f32x16& v) { h16x8 o; _Pragma("unroll") for (int i = 0; i < 8; ++i) o[i] = (h16)v[8 + i]; return o; }
#define MFMA32(a, b, c) __builtin_amdgcn_mfma_f32_32x32x16_f16(a, b, c, 0, 0, 0)

__device__ __forceinline__ void transpose_item(const float* W, int K, int N, h16* WT, const float* kscale, LAS float* scr, int item, int lane) {
    const int nblk = N / 32, kb = item / nblk, nb = item % nblk, k0 = 64 * kb, n0 = 32 * nb;
#pragma unroll 8
    for (int i = 0; i < 32; ++i) { const int kk = 2 * i + (lane >> 5); float v = W[(size_t)(k0 + kk) * N + n0 + (lane & 31)]; if (kscale) v *= kscale[k0 + kk]; scr[kk * 33 + (lane & 31)] = v; }
    asm volatile("s_waitcnt lgkmcnt(0)" ::: "memory");
    const int c = lane & 7;
#pragma unroll
    for (int j = 0; j < 4; ++j) { const int n = (lane >> 3) + 8 * j; const LAS float* s = scr + (8 * c) * 33 + n;
        h16x8 o; _Pragma("unroll") for (int e = 0; e < 8; ++e) o[e] = (h16)s[e * 33];
        *(h16x8*)(WT + (size_t)(n0 + n) * K + k0 + 8 * c) = o; }
    asm volatile("s_waitcnt lgkmcnt(0)" ::: "memory");
}

__device__ __forceinline__ void prologue(const Args& a, LAS unsigned char* lds) {
    int tid_ = threadIdx.x; asm volatile("" : "+v"(tid_));
    const int tid = tid_, lane = tid & 63, wave = tid >> 6;
    const int gw = blockIdx.x * 8 + wave, NGW = gridDim.x * 8;
    LAS float* scr = (LAS float*)(lds + wave * 16384);
    h16* Wb = (h16*)(a.ws + WS_W);
    constexpr int I_IN = (DM / 64) * (ZW / 32), I_AO = (512 / 64) * (DM / 32), I_OUT = (DM / 64) * (DM / 32), I_PE = (PLE / 64) * (DM / 32), I_FM = 4 * (128 / 64) * (128 / 32);
    constexpr int I_L = I_IN + 2 * I_AO + 2 * I_OUT + I_PE + I_FM;
    for (int it = gw; it < DEPTH * I_L; it += NGW) {
        const int l = it / I_L; int r = it % I_L; h16* wl = Wb + (size_t)l * LW_SZ;
        if (r < I_IN) { transpose_item(a.in[5] + (size_t)l * DM * ZW, DM, ZW, wl + LW_IN, a.in[4] + l * DM, scr, r, lane); continue; } r -= I_IN;
        if (r < I_AO) { transpose_item(a.in[8] + (size_t)l * 512 * DM, 512, DM, wl + LW_AO, nullptr, scr, r, lane); continue; } r -= I_AO;
        if (r < I_AO) { transpose_item(a.in[9] + (size_t)l * 512 * DM, 512, DM, wl + LW_FO, nullptr, scr, r, lane); continue; } r -= I_AO;
        if (r < I_OUT) { transpose_item(a.in[10] + (size_t)l * DM * DM, DM, DM, wl + LW_OUT, nullptr, scr, r, lane); continue; } r -= I_OUT;
        if (r < I_OUT) { transpose_item(a.in[13] + (size_t)l * DM * DM, DM, DM, wl + LW_PG, a.in[12] + l * DM, scr, r, lane); continue; } r -= I_OUT;
        if (r < I_PE) { transpose_item(a.in[11] + (size_t)l * PLE * DM, PLE, DM, wl + LW_PE, nullptr, scr, r, lane); continue; } r -= I_PE;
        { const int g = r / 8, rr = r % 8; transpose_item(a.in[7] + ((size_t)l * 4 + g) * 128 * 128, 128, 128, wl + LW_FM + (size_t)g * 128 * 128, nullptr, scr, rr, lane); }
    }
    const int gt = blockIdx.x * 512 + tid, NGT = gridDim.x * 512;
    const float invf[8] = {1.0f, 0.19392274f, 0.03760603f, 0.0072926646f, 0.0014142136f, 0.0002742482f, 5.3182957e-05f, 1.0313385e-05f};
    f32x2* rope = (f32x2*)(a.ws + WS_ROPE);
    for (int i = gt; i < 8192 * 8; i += NGT) { const int pos = i >> 3, j = i & 7;
        float fq = 1.0f; _Pragma("unroll") for (int q = 0; q < 8; ++q) if (j == q) fq = invf[q];
        const float ang = (float)pos * fq; double rev = (double)ang * 0.15915494309189535; rev -= rint(rev);
        float s, c; sincospif((float)(2.0 * rev), &s, &c); rope[i] = (f32x2){c, s}; }
    h16* t1a = (h16*)(a.ws + WS_T1A);
    for (int i = gt; i < 256 * 128; i += NGT) { const int n = i >> 7, c = i & 127, d = n & 127; float s, co; sincospif((float)((d * c) & 127) * (2.0f / 128.0f), &s, &co);
        t1a[i] = (h16)((n < 128 ? co : -s) * 0.08838834764831845f); }
    {   h16* t = (h16*)(a.ws + WS_T1B64);
        for (int i = gt; i < 128 * 128; i += NGT) { const int row = i >> 7, col = i & 127, k1 = row & 63, s1 = col & 63; float s, co; sincospif((float)((k1 * s1) & 63) * (2.0f / 64.0f), &s, &co);
            const float v = (row < 64) ? (col < 64 ? co : s) : (col < 64 ? -s : co); t[i] = (h16)(v * 0.125f); } }
    {   h16* t = (h16*)(a.ws + WS_T1B128);
        for (int i = gt; i < 256 * 256; i += NGT) { const int row = i >> 8, col = i & 255, k1 = row & 127, s1 = col & 127; float s, co; sincospif((float)((k1 * s1) & 127) * (2.0f / 128.0f), &s, &co);
            const float v = (row < 128) ? (col < 128 ? co : s) : (col < 128 ? -s : co); t[i] = (h16)(v * 0.08838834764831845f); } }
    {   h16* t = (h16*)(a.ws + WS_T2);
        for (int i = gt; i < 64 * 128; i += NGT) { const int k2 = i >> 7, col = i & 127, s2 = col & 63; float s, co; sincospif((float)((k2 * s2) & 63) * (2.0f / 64.0f), &s, &co);
            t[i] = (h16)((col < 64 ? co : s) * 0.125f); } }
    {   f32x2* t = (f32x2*)(a.ws + WS_TW64);
        for (int i = gt; i < 64 * 64; i += NGT) { const int k1 = i >> 6, s2 = i & 63; float s, co; sincospif((float)(k1 * s2) * (2.0f / 4096.0f), &s, &co); t[i] = (f32x2){co, s}; } }
    {   f32x2* t = (f32x2*)(a.ws + WS_TW128);
        for (int i = gt; i < 128 * 64; i += NGT) { const int k1 = i >> 6, s2 = i & 63; float s, co; sincospif((float)(k1 * s2) * (2.0f / 8192.0f), &s, &co); t[i] = (f32x2){co, s}; } }
}

__device__ __forceinline__ void group_start(const Grp& G, h16* ha, float* part2) {
    int tid_ = threadIdx.x; asm volatile("" : "+v"(tid_));
    const int lane = tid_ & 63, gw = blockIdx.x * 8 + (tid_ >> 6), NGW = gridDim.x * 8;
    for (int r = gw; r < G.M; r += NGW) {
        const f32x4* xr = (const f32x4*)(G.x + (size_t)r * DM) + lane; float ss = 0.f;
#pragma unroll
        for (int j = 0; j < 4; ++j) { const f32x4 v = xr[64 * j]; ss += (v[0] * v[0] + v[1] * v[1]) + (v[2] * v[2] + v[3] * v[3]);
            h16x4 o = {(h16)v[0], (h16)v[1], (h16)v[2], (h16)v[3]}; *((h16x4*)(ha + (size_t)r * DM) + lane + 64 * j) = o; }
#pragma unroll
        for (int o = 1; o < 64; o <<= 1) ss += __shfl_xor(ss, o);
        if (lane < 16) part2[(size_t)r * 16 + lane] = (lane == 0) ? ss : 0.f;
    }
}
__device__ __forceinline__ void convert_p(const Grp& G, int layer, h16* p16) {
    const f32x4* src = (const f32x4*)(G.p + (size_t)layer * G.p_lstride); const size_t n4 = (size_t)G.M * PLE / 4;
    int tid_ = threadIdx.x; asm volatile("" : "+v"(tid_));
    for (size_t i = (size_t)blockIdx.x * 512 + tid_; i < n4; i += (size_t)gridDim.x * 512) { const f32x4 v = src[i]; h16x4 o = {(h16)v[0], (h16)v[1], (h16)v[2], (h16)v[3]}; ((h16x4*)p16)[i] = o; }
}
__device__ __forceinline__ void final_norm(const Grp& G, const float* part2, const float* lnf) {
    int tid_ = threadIdx.x; asm volatile("" : "+v"(tid_));
    const int lane = tid_ & 63, gw = blockIdx.x * 8 + (tid_ >> 6), NGW = gridDim.x * 8;
    for (int r = gw; r < G.M; r += NGW) {
        const float rs = pg8::rstd_from(part2, r);
        f32x4* xr = (f32x4*)(G.out + (size_t)r * DM) + lane;
#pragma unroll
        for (int j = 0; j < 4; ++j) { const f32x4 w = ((const f32x4*)lnf)[lane + 64 * j]; xr[64 * j] = xr[64 * j] * rs * w; }
    }
}

constexpr int KS_STRIDE = 144, VS_STRIDE = 192, KS_BYTES = 384 * KS_STRIDE;
__device__ __forceinline__ void attn_unit(LAS unsigned char* lds, h16* z, const f32x2* rope, const float* sink, int S, int b, int nb, int g) {
    int tid_ = threadIdx.x; asm volatile("" : "+v"(tid_));
    const int tid = tid_, lane = tid & 63, wid = tid >> 6, l31 = lane & 31, hi = lane >> 5;
    LAS unsigned char* Ks = lds; LAS unsigned char* Vs = lds + KS_BYTES;
    const int kb0 = nb * 128 - 128;
    const size_t rowbase = (size_t)b * S;
#pragma unroll
    for (int i = 0; i < 3; ++i) { const int item = tid + 512 * i, kk = item >> 2, c4 = item & 3, pos = kb0 + kk;
        h16x8 v0 = {}, v1 = {};
        if (pos >= 0 && pos < S) { const h16* src = z + (rowbase + pos) * ZW + C_K + g * 64 + c4 * 16; v0 = ld8(src); v1 = ld8(src + 8);
            if (c4 == 0) { const f32x2* rp = rope + (size_t)pos * 8; h16x8 o0, o1;
                _Pragma("unroll") for (int j = 0; j < 8; ++j) { const f32x2 cs = rp[j]; const float x1 = (float)v0[j], x2 = (float)v1[j]; o0[j] = (h16)(x1 * cs[0] - x2 * cs[1]); o1[j] = (h16)(x2 * cs[0] + x1 * cs[1]); }
                v0 = o0; v1 = o1; } }
        *(LAS h16x8*)(Ks + kk * KS_STRIDE + c4 * 32) = v0; *(LAS h16x8*)(Ks + kk * KS_STRIDE + c4 * 32 + 16) = v1; }
#pragma unroll
    for (int i = 0; i < 6; ++i) { const int item = tid + 512 * i, kk = item >> 3, c8 = item & 7, pos = kb0 + kk;
        h16x8 v = {}; if (pos >= 0 && pos < S) v = ld8(z + (rowbase + pos) * ZW + C_V + g * 64 + c8 * 8);
        *(LAS h16x8*)(Vs + kk * VS_STRIDE + c8 * 16) = v; }
    __syncthreads();
    const float CS = 0.125f * 1.44269504089f;
    const bool edge_block = (nb == 0) || (nb == S / 128 - 1);
    const int blk = (lane >> 4) & 1, q4 = (lane & 15) >> 2, p4 = lane & 3;
#pragma unroll 1
    for (int it = 0; it < 2; ++it) {
        const int item = wid + 8 * it, hh = item >> 2, rg = item & 3, head = g * 4 + hh;
        const int qi = nb * 128 + rg * 32 + l31;
        h16* qrow = z + (rowbase + qi) * ZW + C_Q + head * 64;
        h16x8 qf[4];
        {   const h16x8 a0 = ld8(qrow), a1 = ld8(qrow + 8); const f32x2* rp = rope + (size_t)qi * 8; h16x8 o;
            _Pragma("unroll") for (int j = 0; j < 8; ++j) { const f32x2 cs = rp[j]; const float x1 = (float)a0[j], x2 = (float)a1[j]; o[j] = hi ? (h16)(x2 * cs[0] + x1 * cs[1]) : (h16)(x1 * cs[0] - x2 * cs[1]); }
            qf[0] = o; }
#pragma unroll
        for (int ks = 1; ks < 4; ++ks) qf[ks] = ld8(qrow + 16 * ks + 8 * hi);
        const float sk = sink[head] * 1.44269504089f;
        float mrun = sk, lrun = hi ? 0.f : 1.f;
        f32x16 o0 = {}, o1 = {};
#pragma unroll 1
        for (int tt = 0; tt < 9; ++tt) {
            const int t = rg + tt;
            f32x16 st = {};
            const LAS unsigned char* kp = Ks + (32 * t + l31) * KS_STRIDE + hi * 16;
#pragma unroll
            for (int ks = 0; ks < 4; ++ks) st = MFMA32(*(const LAS h16x8*)(kp + ks * 32), qf[ks], st);
            const bool need_mask = edge_block || tt == 0 || tt == 8;
            float mx = -3.0e38f;
#pragma unroll
            for (int j = 0; j < 16; ++j) { float s = st[j] * CS;
                if (need_mask) { const int pos = kb0 + 32 * t + (j & 3) + 8 * (j >> 2) + 4 * hi; const int rel = pos - qi; const bool ok = (pos >= 0) && (pos < S) && (rel <= 128) && (rel >= -128); s = ok ? s : -1.0e30f; }
                st[j] = s; mx = fmaxf(mx, s); }
            mx = fmaxf(mx, __shfl_xor(mx, 32));
            const float mnew = fmaxf(mrun, mx), alpha = __builtin_amdgcn_exp2f(mrun - mnew);
            mrun = mnew; float ps = 0.f;
#pragma unroll
            for (int j = 0; j < 16; ++j) { const float p = __builtin_amdgcn_exp2f(st[j] - mnew); st[j] = p; ps += p; }
            lrun = lrun * alpha + ps;
#pragma unroll
            for (int j = 0; j < 16; ++j) { o0[j] *= alpha; o1[j] *= alpha; }
            const h16x8 pk0 = pack_lo(st), pk1 = pack_hi(st);
            const LAS unsigned char* vp = Vs + (32 * t + 4 * hi + q4) * VS_STRIDE + (16 * blk + 4 * p4) * 2;
#pragma unroll
            for (int u = 0; u < 2; ++u) {
                const h16x8 va0 = cat8(tr4(vp + (16 * u) * VS_STRIDE), tr4(vp + (16 * u + 8) * VS_STRIDE));
                const h16x8 va1 = cat8(tr4(vp + (16 * u) * VS_STRIDE + 64), tr4(vp + (16 * u + 8) * VS_STRIDE + 64));
                o0 = MFMA32(va0, u ? pk1 : pk0, o0); o1 = MFMA32(va1, u ? pk1 : pk0, o1);
            }
        }
        const float ltot = lrun + __shfl_xor(lrun, 32), inv = 1.0f / ltot;
        const h16* garow = z + (rowbase + qi) * ZW + C_GA + head * 64;
#pragma unroll
        for (int mb = 0; mb < 2; ++mb)
#pragma unroll
            for (int jg = 0; jg < 4; ++jg) { const int d = 32 * mb + 8 * jg + 4 * hi; const h16x4 gv = ld4(garow + d); h16x4 o;
                _Pragma("unroll") for (int e = 0; e < 4; ++e) { const float ga = (float)gv[e]; const float ov = (mb ? o1[4 * jg + e] : o0[4 * jg + e]) * inv; o[e] = (h16)(ov * ga * sigm(ga)); }
                *(h16x4*)(qrow + d) = o; }
    }
    __syncthreads();
}

template <int N1>
__device__ __forceinline__ void f1_unit(LAS unsigned char* lds, const h16* z, h16* Gb, const h16* t1a, const h16* t1b, const f32x2* tw, int S, int b, int s2) {
    constexpr int US = 1040, NRB = N1 / 32;
    int tid_ = threadIdx.x; asm volatile("" : "+v"(tid_));
    const int tid = tid_, lane = tid & 63, wid = tid >> 6, l31 = lane & 31, hi = lane >> 5;
    const size_t rowbase = (size_t)b * S;
#pragma unroll
    for (int i = 0; i < N1 / 8; ++i) { const int item = tid + 512 * i, s1 = item >> 6, ch = item & 63;
        *(LAS h16x8*)(lds + s1 * US + ch * 16) = ld8(z + (rowbase + 64 * s1 + s2) * ZW + C_UF + ch * 8); }
    __syncthreads();
#pragma unroll 1
    for (int dbi = 0; dbi < 2; ++dbi) {
        const int db = wid * 2 + dbi, g = db >> 2, dq = db & 3;
        h16x8 Xs[2][NRB][2];
#pragma unroll
        for (int part = 0; part < 2; ++part) {
            h16x8 bf[8];
#pragma unroll
            for (int ks = 0; ks < 8; ++ks) bf[ks] = ld8(t1a + (size_t)(part * 128 + dq * 32 + l31) * 128 + 16 * ks + 8 * hi);
#pragma unroll
            for (int rb = 0; rb < NRB; ++rb) { f32x16 acc = {};
                const LAS unsigned char* up = lds + (rb * 32 + l31) * US + (g * 128 + 8 * hi) * 2;
#pragma unroll
                for (int ks = 0; ks < 8; ++ks) acc = MFMA32(*(const LAS h16x8*)(up + ks * 32), bf[ks], acc);
                Xs[part][rb][0] = pack_lo(acc); Xs[part][rb][1] = pack_hi(acc); }
        }
#pragma unroll 1
        for (int kb = 0; kb < NRB; ++kb) {
            f32x16 aR = {}, aI = {};
            const h16* wR = t1b + (size_t)(kb * 32 + l31) * (2 * N1) + 4 * hi; const h16* wI = wR + (size_t)N1 * (2 * N1);
#pragma unroll
            for (int part = 0; part < 2; ++part)
#pragma unroll
                for (int rb = 0; rb < NRB; ++rb)
#pragma unroll
                    for (int t = 0; t < 2; ++t) { const int co = part * N1 + rb * 32 + 16 * t;
                        aR = MFMA32(Xs[part][rb][t], cat8(ld4(wR + co), ld4(wR + co + 8)), aR);
                        aI = MFMA32(Xs[part][rb][t], cat8(ld4(wI + co), ld4(wI + co + 8)), aI);
                        if (N1 == 128 && t == 1) __builtin_amdgcn_sched_barrier(0); }
            const int k1 = kb * 32 + l31; const f32x2 cs = tw[k1 * 64 + s2];
            h16* grow = Gb + (rowbase + (size_t)k1 * 64 + s2) * 1024 + g * 256 + dq * 32 + 4 * hi;
#pragma unroll
            for (int jg = 0; jg < 4; ++jg) { h16x4 orr, oi;
                _Pragma("unroll") for (int e = 0; e < 4; ++e) { const float gr = aR[4 * jg + e], gi = aI[4 * jg + e]; orr[e] = (h16)(gr * cs[0] + gi * cs[1]); oi[e] = (h16)(gi * cs[0] - gr * cs[1]); }
                *(h16x4*)(grow + 8 * jg) = orr; *(h16x4*)(grow + 128 + 8 * jg) = oi; }
        }
    }
    __syncthreads();
}

__device__ __forceinline__ void f2_unit(LAS unsigned char* lds, h16* z, const h16* Gb, const h16* wfm, const h16x8 (&bt2)[8], int S, int N1, int b, int k1) {
    constexpr int GS = 2112;
    int tid_ = threadIdx.x; asm volatile("" : "+v"(tid_));
    const int tid = tid_, lane = tid & 63, wid = tid >> 6, l31 = lane & 31, hi = lane >> 5;
    const int blk = (lane >> 4) & 1, q4 = (lane & 15) >> 2, p4 = lane & 3;
    const size_t rowbase = (size_t)b * S;
    const h16* gsrc = Gb + (rowbase + (size_t)k1 * 64) * 1024;
#pragma unroll
    for (int i = 0; i < 16; ++i) { const int item = tid + 512 * i, s2 = item >> 7, ch = item & 127;
        *(LAS h16x8*)(lds + s2 * GS + ch * 16) = ld8(gsrc + (size_t)s2 * 1024 + ch * 8); }
    __syncthreads();
    const int g = wid >> 1, kb2 = wid & 1;
    h16x8 Ys[4][2];
#pragma unroll
    for (int db = 0; db < 4; ++db) { f32x16 acc = {};
#pragma unroll
        for (int kk = 0; kk < 8; ++kk) { const int part = kk >> 2, ks = kk & 3;
            const LAS unsigned char* ap = lds + (16 * ks + 8 * hi + q4) * GS + (g * 256 + part * 128 + 32 * db + 16 * blk + 4 * p4) * 2;
            acc = MFMA32(cat8(tr4(ap), tr4(ap + 4 * GS)), bt2[kk], acc); }
        Ys[db][0] = pack_lo(acc); Ys[db][1] = pack_hi(acc); }
    const int k2 = kb2 * 32 + l31; const size_t trow = rowbase + k1 + (size_t)N1 * k2;
    const h16* gfrow = z + trow * ZW + C_GF + g * 128; h16* frow = z + trow * ZW + C_UF + g * 128;
    const h16* wg = wfm + (size_t)g * 128 * 128;
#pragma unroll 1
    for (int ob = 0; ob < 4; ++ob) { f32x16 acc = {};
        const h16* wr = wg + (size_t)(ob * 32 + l31) * 128 + 4 * hi;
#pragma unroll
        for (int db = 0; db < 4; ++db)
#pragma unroll
            for (int t = 0; t < 2; ++t) { const int co = 32 * db + 16 * t; acc = MFMA32(cat8(ld4(wr + co), ld4(wr + co + 8)), Ys[db][t], acc); }
#pragma unroll
        for (int jg = 0; jg < 4; ++jg) { const int d = 32 * ob + 8 * jg + 4 * hi; const h16x4 gv = ld4(gfrow + d); h16x4 o;
            _Pragma("unroll") for (int e = 0; e < 4; ++e) { const float gf = (float)gv[e]; o[e] = (h16)(acc[4 * jg + e] * gf * sigm(gf)); }
            *(h16x4*)(frow + d) = o; }
    }
    __syncthreads();
}

#ifndef PHM
#define PHM 0xFFFF
#endif
constexpr int STEPS_PER_GROUP = 2 + DEPTH * 6;
constexpr int N_STEPS = 1 + 2 * STEPS_PER_GROUP;

__global__ void __launch_bounds__(512, 2) fwd_megakernel(Args args) {
    extern __shared__ __attribute__((aligned(16))) unsigned char lds_raw[];
    LAS unsigned char* lds = (LAS unsigned char*)lds_raw;
    cg::grid_group grid = cg::this_grid();
    unsigned char* ws = args.ws;
    h16* z = (h16*)(ws + WS_Z); h16* Gb = (h16*)(ws + WS_G); h16* ha = (h16*)(ws + WS_HA); h16* p16 = (h16*)(ws + WS_P16);
    float* part1 = (float*)(ws + WS_PART1); float* part2 = (float*)(ws + WS_PART2);
    const h16* Wb = (const h16*)(ws + WS_W);
    const f32x2* rope = (const f32x2*)(ws + WS_ROPE);
    const int Gsz = gridDim.x, cid = blockIdx.x;

    for (int step = args.step_lo; step < args.step_hi; ++step) {
        if (step > args.step_lo) grid.sync();
        if (step == 0) { if (PHM & 256) prologue(args, lds); __syncthreads(); continue; }
        const int gi = (step - 1) / STEPS_PER_GROUP, ls = (step - 1) % STEPS_PER_GROUP;
        Grp G;
        if (gi == 0) { G.B = 16; G.S = 4096; G.N1 = 64; G.x = args.in[0]; G.p = args.in[2]; G.out = args.out; G.p_lstride = (size_t)16 * 4096 * PLE; }
        else { G.B = 4; G.S = 8192; G.N1 = 128; G.x = args.in[1]; G.p = args.in[3]; G.out = args.out + (size_t)16 * 4096 * DM; G.p_lstride = (size_t)4 * 8192 * PLE; }
        G.M = G.B * G.S;
        if (ls == 0) { if (PHM & 512) group_start(G, ha, part2); continue; }
        if (ls == STEPS_PER_GROUP - 1) { if (PHM & 1024) final_norm(G, part2, args.in[14]); continue; }
        const int layer = (ls - 1) / 6, ph = (ls - 1) % 6;
        const h16* wl = Wb + (size_t)layer * LW_SZ;
        pg8::StaticOrder SO;
        if (ph == 0 && (PHM & 1)) {
            pg8::Gemm gm{ha, DM, wl + LW_IN, G.M, ZW, DM}; SO.init(G.M, ZW, Gsz, cid);
            pg8::EpiZ E{z, part2}; pg8::gemm_phase(lds, gm, SO, E);
        } else if (ph == 1 && (PHM & 2)) {
            const int nblk = G.S / 128, nA = G.B * nblk * 2;
            const float* sink = args.in[6] + layer * 8;
            if (PHM & 64) for (int u = cid; u < nA; u += Gsz) { const int g = u & 1, nb = (u >> 1) % nblk, b = (u >> 1) / nblk; attn_unit(lds, z, rope, sink, G.S, b, nb, g); }
            const int nF = G.B * 64;
            const h16* t1a = (const h16*)(ws + WS_T1A);
            if (G.N1 == 64 && (PHM & 128)) { const h16* t1b = (const h16*)(ws + WS_T1B64); const f32x2* tw = (const f32x2*)(ws + WS_TW64);
                for (int u = cid; u < nF; u += Gsz) f1_unit<64>(lds, z, Gb, t1a, t1b, tw, G.S, u >> 6, u & 63); }
            else if (PHM & 2048) { const h16* t1b = (const h16*)(ws + WS_T1B128); const f32x2* tw = (const f32x2*)(ws + WS_TW128);
                for (int u = cid; u < nF; u += Gsz) f1_unit<128>(lds, z, Gb, t1a, t1b, tw, G.S, u >> 6, u & 63); }
        } else if (ph == 2 && (PHM & 4)) {
            convert_p(G, layer, p16);
            const h16* t2 = (const h16*)(ws + WS_T2);
            int tid_ = threadIdx.x; asm volatile("" : "+v"(tid_));
            const int lane = tid_ & 63, wid = tid_ >> 6, kb2 = wid & 1;
            h16x8 bt2[8];
#pragma unroll
            for (int kk = 0; kk < 8; ++kk) bt2[kk] = ld8(t2 + (size_t)(kb2 * 32 + (lane & 31)) * 128 + (kk >> 2) * 64 + 16 * (kk & 3) + 8 * (lane >> 5));
            const int nU = G.B * G.N1;
            for (int u = cid; u < nU; u += Gsz) f2_unit(lds, z, Gb, wl + LW_FM, bt2, G.S, G.N1, u / G.N1, u % G.N1);
        } else if (ph == 3 && (PHM & 8)) {
            SO.init(G.M, DM, Gsz, cid);
            { pg8::Gemm gm{z + C_Q, ZW, wl + LW_AO, G.M, DM, 512}; pg8::EpiD1 E{z}; pg8::gemm_phase(lds, gm, SO, E); }
            { pg8::Gemm gm{z + C_UF, ZW, wl + LW_FO, G.M, DM, 512}; pg8::EpiD2 E{z}; pg8::gemm_phase(lds, gm, SO, E); }
        } else if (ph == 4 && (PHM & 16)) {
            SO.init(G.M, DM, Gsz, cid);
            pg8::Gemm gm{z + C_MGA, ZW, wl + LW_OUT, G.M, DM, DM}; pg8::EpiE E{layer == 0 ? G.x : (const float*)G.out, G.out, z, part1}; pg8::gemm_phase(lds, gm, SO, E);
        } else if (ph == 5 && (PHM & 32)) {
            SO.init(G.M, DM, Gsz, cid);
            { pg8::Gemm gm{z + C_MGF, ZW, wl + LW_PG, G.M, DM, DM}; pg8::EpiF1 E{z, part1}; pg8::gemm_phase(lds, gm, SO, E); }
            { pg8::Gemm gm{p16, PLE, wl + LW_PE, G.M, DM, PLE}; pg8::EpiF2 E{G.out, z, ha, part2}; pg8::gemm_phase(lds, gm, SO, E); }
        }
    }
}

extern "C" void kernel_launch(void* const* d_in, const int* in_sizes, int n_in, void* d_out, int out_size, void* d_ws, size_t ws_size, hipStream_t stream) {
    static int grid = 0;
    if (grid == 0) {
        if (n_in != 15 || ws_size < WS_END) { fprintf(stderr, "kernel_launch: need 15 inputs and %zu bytes of workspace (got %d, %zu)\n", (size_t)WS_END, n_in, ws_size); grid = -1; return; }
        int dev = 0, cus = 0, per_cu = 0;
        (void)hipGetDevice(&dev); (void)hipDeviceGetAttribute(&cus, hipDeviceAttributeMultiprocessorCount, dev);
        if (hipFuncSetAttribute((const void*)fwd_megakernel, hipFuncAttributeMaxDynamicSharedMemorySize, LDS_BYTES) != hipSuccess) { fprintf(stderr, "kernel_launch: hipFuncSetAttribute failed\n"); grid = -1; return; }
        if (hipOccupancyMaxActiveBlocksPerMultiprocessor(&per_cu, (const void*)fwd_megakernel, 512, LDS_BYTES) != hipSuccess || per_cu < 1) { fprintf(stderr, "kernel_launch: occupancy query says %d\n", per_cu); per_cu = 1; }
        (void)hipGetLastError();
        grid = cus;
    }
    if (grid < 0) return;
    Args a{};
    for (int i = 0; i < 15; ++i) a.in[i] = (const float*)d_in[i];
    a.out = (float*)d_out; a.ws = (unsigned char*)d_ws; a.step_lo = 0; a.step_hi = N_STEPS;
    void* kargs[] = {&a};
    hipError_t e = hipLaunchCooperativeKernel((const void*)fwd_megakernel, dim3(grid), dim3(512), kargs, LDS_BYTES, stream);
    if (e != hipSuccess) fprintf(stderr, "kernel_launch: cooperative launch failed: %s (grid %d)\n", hipGetErrorString(e), grid);
}
```

```cpp
#include <hip/hip_runtime.h>
#include <hip/hip_cooperative_groups.h>
#include <cstdio>
#include <cstdint>
namespace cg = cooperative_groups;

#define LAS __attribute__((address_space(3)))
typedef _Float16 h16;
typedef _Float16 h16x8 __attribute__((ext_vector_type(8)));
typedef _Float16 h16x4 __attribute__((ext_vector_type(4)));
typedef _Float16 h16x2 __attribute__((ext_vector_type(2)));
typedef float f32x4 __attribute__((ext_vector_type(4)));
typedef float f32x2 __attribute__((ext_vector_type(2)));
typedef float f32x16 __attribute__((ext_vector_type(16)));
typedef short v4i16_t __attribute__((ext_vector_type(4)));

constexpr int DM = 1024, DEPTH = 4, ZW = 4352, PLE = 256;
constexpr int C_Q = 0, C_K = 512, C_V = 640, C_GA = 768, C_UF = 1280, C_GF = 1792, C_MGA = 2304, C_MGF = 3328;
constexpr int MG_MAX = 65536;
constexpr float EPS = 1e-6f;
constexpr size_t LW_IN = 0, LW_AO = LW_IN + (size_t)ZW * DM, LW_FO = LW_AO + (size_t)DM * 512, LW_OUT = LW_FO + (size_t)DM * 512,
                 LW_PG = LW_OUT + (size_t)DM * DM, LW_PE = LW_PG + (size_t)DM * DM, LW_FM = LW_PE + (size_t)DM * PLE, LW_SZ = LW_FM + 4 * 128 * 128;
constexpr size_t WS_Z = 0;
constexpr size_t WS_G = WS_Z + (size_t)MG_MAX * ZW * 2;
constexpr size_t WS_HA = WS_G + (size_t)MG_MAX * 2048;
constexpr size_t WS_P16 = WS_HA + (size_t)MG_MAX * 2048;
constexpr size_t WS_PART1 = WS_P16 + (size_t)MG_MAX * 512;
constexpr size_t WS_PART2 = WS_PART1 + (size_t)MG_MAX * 64;
constexpr size_t WS_W = WS_PART2 + (size_t)MG_MAX * 64;
constexpr size_t WS_ROPE = WS_W + (size_t)DEPTH * LW_SZ * 2;
constexpr size_t WS_T1A = WS_ROPE + 8192 * 8 * 8;
constexpr size_t WS_T1B64 = WS_T1A + 256 * 128 * 2;
constexpr size_t WS_T1B128 = WS_T1B64 + 128 * 128 * 2;
constexpr size_t WS_T2 = WS_T1B128 + 256 * 256 * 2;
constexpr size_t WS_TW64 = WS_T2 + 64 * 128 * 2;
constexpr size_t WS_TW128 = WS_TW64 + 64 * 64 * 8;
constexpr size_t WS_BAR = WS_TW128 + 128 * 64 * 8;
constexpr size_t WS_BAR_BYTES = 16384;
constexpr size_t WS_END = WS_BAR + WS_BAR_BYTES;

constexpr int GRID = 256;
constexpr int LDS_CTL_OFF = 139264;
constexpr int LDS_BYTES = 139264 + 64;

__device__ __forceinline__ float sigm(float x) { return __builtin_amdgcn_rcpf(1.0f + __builtin_amdgcn_exp2f(-1.44269504089f * x)); }

namespace pg8 {
constexpr int BM = 256, BK = 64, HALF = 128, HTB = HALF * BK * 2, NXCD = 8, WGM = 8;
__device__ __forceinline__ int lds_byte(int r, int c) { const int st = (r >> 4) * 2 + (c >> 5), rr = r & 15, cc = c & 31, ob = rr * 64 + cc * 2; return st * 1024 + (ob ^ (((ob >> 9) & 1) << 5)); }
__device__ __forceinline__ void stage_rc(int b, int& R, int& C) { const int st = b / 1024, sb = b % 1024, swz = sb ^ (((sb >> 9) & 1) << 5); R = (st >> 1) * 16 + swz / 64; C = (st & 1) * 32 + (swz % 64) / 2; }
__device__ __forceinline__ int perm32(int rho) { const int n = rho >> 4, i = rho & 15; return 8 * (i >> 2) + 4 * n + (i & 3); }
struct Unit { int pm, pn; };
struct Gemm { const h16* A; int lda; const h16* Bt; int M, N, K; };
template <int NN> struct StaticOrder {
    int nwg, G, c;
    __device__ void init(int M, int G_, int c_) { nwg = (M / BM) * NN; G = G_; c = c_; }
    __device__ bool next(int i, Unit& u) const {
        const long L = (long)i * G + c; if (L >= nwg) return false;
        int wgid = (int)L; { const int q = nwg / NXCD, r = nwg % NXCD, xcd = wgid % NXCD, off = wgid / NXCD; wgid = (xcd < r ? xcd * (q + 1) : r * (q + 1) + (xcd - r) * q) + off; }
        constexpr int nig = WGM * NN; const int gid = wgid / nig, fm = gid * WGM;
        u.pm = fm + ((wgid % nig) % WGM); u.pn = (wgid % nig) / WGM; return true;
    }
};
typedef f32x4 Acc[2][2][4][2];

template <class Epi, class Sched>
__device__ __forceinline__ void gemm_phase(LAS unsigned char* lds, const Gemm g, const Sched& S, const Epi& E) {
    int tid_ = threadIdx.x; asm volatile("" : "+v"(tid_));
    const int tid = tid_, wid = __builtin_amdgcn_readfirstlane(tid >> 6), lane = tid & 63, wr = wid >> 2, wc = wid & 3, fr = lane & 15, fq = lane >> 4;
    const int K = g.K, nt = K / BK;
    unsigned voffA[2], voffB[2];
#pragma unroll
    for (int i = 0; i < 2; ++i) { int R, C; stage_rc(tid * 16 + i * 8192, R, C); const int Rb = (R & ~31) + perm32(R & 31);
        voffA[i] = (unsigned)(R * g.lda + C) * 2u; voffB[i] = (unsigned)(Rb * K + C) * 2u; }
    const size_t kstep = (size_t)(BK * 2);
    const size_t hstepA = (size_t)HALF * g.lda * 2, tstepA = 2 * hstepA;
    const size_t hstepB = (size_t)HALF * K * 2, tstepB = 2 * hstepB;
    const unsigned ldsw = (unsigned)wid * 1024u;
    const int aoff = lds_byte(wr * 64 + fr, fq * 8), boff = lds_byte(wc * 32 + fr, fq * 8);
#define PG8_SA(b, h) (((b) * 2 + (h)) * HTB)
#define PG8_SB(b, h) ((4 + (b) * 2 + (h)) * HTB)
#define PG8_STAGE(bufoff, gbase, voff) do { _Pragma("unroll") for (int _i = 0; _i < 2; ++_i) \
        __builtin_amdgcn_global_load_lds((const unsigned*)((const char*)(gbase) + (voff)[_i]), (LAS unsigned*)(lds + (bufoff) + ldsw + _i * 8192), 16, 0, 0); } while (0)
#define PG8_LDA(dst, b, h) do { _Pragma("unroll") for (int m = 0; m < 4; ++m) _Pragma("unroll") for (int k = 0; k < 2; ++k) dst[m][k] = *(const LAS h16x8*)(lds + PG8_SA(b, h) + aoff + m * 2048 + k * 1024); } while (0)
#define PG8_LDB(dst, b, h) do { _Pragma("unroll") for (int n = 0; n < 2; ++n) _Pragma("unroll") for (int k = 0; k < 2; ++k) dst[n][k] = *(const LAS h16x8*)(lds + PG8_SB(b, h) + boff + n * 2048 + k * 1024); } while (0)
#define PG8_MMA(ai, bj, At, Bt) do { __builtin_amdgcn_s_setprio(1); _Pragma("unroll") for (int m = 0; m < 4; ++m) _Pragma("unroll") for (int n = 0; n < 2; ++n) _Pragma("unroll") for (int k = 0; k < 2; ++k) \
        acc[ai][bj][m][n] = __builtin_amdgcn_mfma_f32_16x16x32_f16(Bt[n][k], At[m][k], acc[ai][bj][m][n], 0, 0, 0); __builtin_amdgcn_s_setprio(0); } while (0)
#define PG8_WAIT_V(n) asm volatile("s_waitcnt vmcnt(" #n ")" ::: "memory")
#define PG8_WAIT_L(n) asm volatile("s_waitcnt lgkmcnt(" #n ")" ::: "memory")
#define PG8_BAR __builtin_amdgcn_s_barrier()
#define PG8_SCHED __builtin_amdgcn_sched_barrier(0)
    Unit cur, nxt; int ui = 0;
    if (!S.next(0, cur)) return;
    Acc acc;
#pragma unroll
    for (int a = 0; a < 2; ++a)
#pragma unroll
        for (int b = 0; b < 2; ++b)
#pragma unroll
            for (int m = 0; m < 4; ++m)
#pragma unroll
                for (int n = 0; n < 2; ++n) acc[a][b][m][n] = (f32x4){0.f, 0.f, 0.f, 0.f};
    h16x8 At[4][2], B0[2][2], B1[2][2];
    const char* cA = (const char*)g.A + (size_t)cur.pm * tstepA; const char* cB = (const char*)g.Bt + (size_t)cur.pn * tstepB;
    PG8_STAGE(PG8_SB(0, 0), cB, voffB); PG8_STAGE(PG8_SB(0, 1), cB + hstepB, voffB); PG8_STAGE(PG8_SA(0, 0), cA, voffA); PG8_STAGE(PG8_SA(0, 1), cA + hstepA, voffA);
    if (wr == 1) PG8_BAR;
    PG8_WAIT_V(2); PG8_BAR;
    PG8_STAGE(PG8_SB(1, 0), cB + kstep, voffB); PG8_STAGE(PG8_SA(1, 0), cA + kstep, voffA); PG8_STAGE(PG8_SB(1, 1), cB + hstepB + kstep, voffB);
    PG8_WAIT_V(6); PG8_BAR;
    for (;;) {
        const bool has_next = S.next(ui + 1, nxt);
        const char* nA = has_next ? (const char*)g.A + (size_t)nxt.pm * tstepA : cA; const char* nB = has_next ? (const char*)g.Bt + (size_t)nxt.pn * tstepB : cB;
        for (int t = 0; t < nt; t += 2) {
            const bool last = (t == nt - 2);
            const char* a1 = cA + (size_t)(t + 1) * kstep;
            const char* a2 = last ? nA : cA + (size_t)(t + 2) * kstep; const char* b2 = last ? nB : cB + (size_t)(t + 2) * kstep;
            const char* a3 = a2 + kstep; const char* b3 = b2 + kstep;
            PG8_LDB(B0, 0, 0); PG8_LDB(B1, 0, 1); PG8_SCHED; PG8_LDA(At, 0, 0); PG8_STAGE(PG8_SA(1, 1), a1 + hstepA, voffA);
            PG8_WAIT_V(8); PG8_WAIT_L(0); PG8_BAR; PG8_MMA(0, 0, At, B0); PG8_MMA(0, 1, At, B1); PG8_BAR; PG8_SCHED;
            PG8_LDA(At, 0, 1); PG8_STAGE(PG8_SB(0, 0), b2, voffB); PG8_STAGE(PG8_SB(0, 1), b2 + hstepB, voffB); PG8_STAGE(PG8_SA(0, 0), a2, voffA);
            PG8_WAIT_V(8); PG8_WAIT_L(0); PG8_BAR; PG8_MMA(1, 0, At, B0); PG8_MMA(1, 1, At, B1); PG8_BAR; PG8_SCHED;
            PG8_LDB(B0, 1, 0); PG8_LDB(B1, 1, 1); PG8_SCHED; PG8_LDA(At, 1, 0); PG8_STAGE(PG8_SA(0, 1), a2 + hstepA, voffA);
            PG8_WAIT_V(8); PG8_WAIT_L(0); PG8_BAR; PG8_MMA(0, 0, At, B0); PG8_MMA(0, 1, At, B1); PG8_BAR; PG8_SCHED;
            PG8_LDA(At, 1, 1); PG8_STAGE(PG8_SB(1, 0), b3, voffB); PG8_STAGE(PG8_SB(1, 1), b3 + hstepB, voffB); PG8_STAGE(PG8_SA(1, 0), a3, voffA);
            PG8_WAIT_V(8); PG8_WAIT_L(0); PG8_BAR; PG8_MMA(1, 0, At, B0); PG8_MMA(1, 1, At, B1); PG8_BAR; PG8_SCHED;
        }
        if (wr == 0) PG8_BAR;
        { int t2 = threadIdx.x; asm volatile("" : "+v"(t2)); const int w2 = __builtin_amdgcn_readfirstlane(t2 >> 6), l2 = t2 & 63; E(acc, cur, w2 >> 2, w2 & 3, l2 & 15, l2 >> 4); }
        if (!has_next) break;
#pragma unroll
        for (int a = 0; a < 2; ++a)
#pragma unroll
            for (int b = 0; b < 2; ++b)
#pragma unroll
                for (int m = 0; m < 4; ++m)
#pragma unroll
                    for (int n = 0; n < 2; ++n) acc[a][b][m][n] = (f32x4){0.f, 0.f, 0.f, 0.f};
        cur = nxt; cA = nA; cB = nB; ++ui;
        if (wr == 1) PG8_BAR;
    }
    PG8_WAIT_V(0);
    PG8_BAR;
#undef PG8_SA
#undef PG8_SB
#undef PG8_STAGE
#undef PG8_LDA
#undef PG8_LDB
#undef PG8_MMA
#undef PG8_WAIT_V
#undef PG8_WAIT_L
#undef PG8_BAR
#undef PG8_SCHED
}

#define EPI_ROWS(...) _Pragma("unroll") for (int ai = 0; ai < 2; ++ai) _Pragma("unroll") for (int m = 0; m < 4; ++m) { const int r = u.pm * BM + ai * HALF + wr * 64 + m * 16 + fr; __VA_ARGS__ asm volatile("" ::: "memory"); }
#define EPI_COLS(...) _Pragma("unroll") for (int bj = 0; bj < 2; ++bj) { const int c = u.pn * BM + bj * HALF + wc * 32 + 8 * fq; const f32x4 v0 = acc[ai][bj][m][0], v1 = acc[ai][bj][m][1]; __VA_ARGS__ }
__device__ __forceinline__ float rstd_from(const float* part, int r) {
    const f32x4* pp = (const f32x4*)(part + (size_t)r * 16); const f32x4 a = pp[0], b = pp[1], c = pp[2], d = pp[3];
    const float ss = ((a[0] + a[1]) + (a[2] + a[3])) + ((b[0] + b[1]) + (b[2] + b[3])) + ((c[0] + c[1]) + (c[2] + c[3])) + ((d[0] + d[1]) + (d[2] + d[3]));
    return __builtin_amdgcn_rsqf(ss * (1.0f / 1024.0f) + EPS);
}
__device__ __forceinline__ h16x8 pack8(f32x4 a, f32x4 b) { h16x8 o; o[0] = (h16)a[0]; o[1] = (h16)a[1]; o[2] = (h16)a[2]; o[3] = (h16)a[3]; o[4] = (h16)b[0]; o[5] = (h16)b[1]; o[6] = (h16)b[2]; o[7] = (h16)b[3]; return o; }
struct EpiZ { h16* z; const float* part; bool dry;
    __device__ __forceinline__ void operator()(const Acc& acc, const Unit& u, int wr, int wc, int fr, int fq) const {
        EPI_ROWS( const float rs = rstd_from(part, r); EPI_COLS( if (!dry) *(h16x8*)(z + (size_t)r * ZW + c) = pack8(v0 * rs, v1 * rs); ) )
    } };
struct EpiD1 { h16* z; bool dry;
    __device__ __forceinline__ void operator()(const Acc& acc, const Unit& u, int wr, int wc, int fr, int fq) const {
        EPI_ROWS( EPI_COLS( h16x8* p = (h16x8*)(z + (size_t)r * ZW + C_MGA + c); const h16x8 gte = *p; h16x8 o;
            _Pragma("unroll") for (int i = 0; i < 4; ++i) { o[i] = (h16)(v0[i] * sigm((float)gte[i])); o[4 + i] = (h16)(v1[i] * sigm((float)gte[4 + i])); } if (!dry) *p = o; ) )
    } };
struct EpiD2 { h16* z; bool dry;
    __device__ __forceinline__ void operator()(const Acc& acc, const Unit& u, int wr, int wc, int fr, int fq) const {
        EPI_ROWS( EPI_COLS( h16x8* p = (h16x8*)(z + (size_t)r * ZW + C_MGA + c); const h16x8 t1 = *p; const h16x8 gte = *(const h16x8*)(z + (size_t)r * ZW + C_MGF + c); h16x8 o;
            _Pragma("unroll") for (int i = 0; i < 4; ++i) { o[i] = (h16)((float)t1[i] + v0[i] * sigm((float)gte[i])); o[4 + i] = (h16)((float)t1[4 + i] + v1[i] * sigm((float)gte[4 + i])); } if (!dry) *p = o; ) )
    } };
struct EpiE { const float* hsrc; float* out; h16* z; float* part; bool dry;
    __device__ __forceinline__ void operator()(const Acc& acc, const Unit& u, int wr, int wc, int fr, int fq) const {
        EPI_ROWS( float ss = 0.f;
            EPI_COLS( const f32x4* hp = (const f32x4*)(hsrc + (size_t)r * DM + c); const f32x4 a = hp[0] + v0, b = hp[1] + v1; f32x4* op = (f32x4*)(out + (size_t)r * DM + c); if (!dry) { op[0] = a; op[1] = b;
                *(h16x8*)(z + (size_t)r * ZW + C_MGF + c) = pack8(a, b); } ss += (a[0] * a[0] + a[1] * a[1]) + (a[2] * a[2] + a[3] * a[3]) + (b[0] * b[0] + b[1] * b[1]) + (b[2] * b[2] + b[3] * b[3]); )
            ss += __shfl_xor(ss, 16); ss += __shfl_xor(ss, 32); if (fq == 0 && !dry) part[(size_t)r * 16 + u.pn * 4 + wc] = ss; )
    } };
struct EpiF1 { h16* z; const float* part; bool dry;
    __device__ __forceinline__ void operator()(const Acc& acc, const Unit& u, int wr, int wc, int fr, int fq) const {
        EPI_ROWS( const float rs = rstd_from(part, r); EPI_COLS( h16x8 o;
            _Pragma("unroll") for (int i = 0; i < 4; ++i) { o[i] = (h16)sigm(v0[i] * rs); o[4 + i] = (h16)sigm(v1[i] * rs); } if (!dry) *(h16x8*)(z + (size_t)r * ZW + C_MGA + c) = o; ) )
    } };
struct EpiF2 { float* out; const h16* z; h16* ha; float* part; bool dry;
    __device__ __forceinline__ void operator()(const Acc& acc, const Unit& u, int wr, int wc, int fr, int fq) const {
        EPI_ROWS( float ss = 0.f;
            EPI_COLS( const h16x8 gt = *(const h16x8*)(z + (size_t)r * ZW + C_MGA + c); f32x4* op = (f32x4*)(out + (size_t)r * DM + c); f32x4 a = op[0], b = op[1];
                _Pragma("unroll") for (int i = 0; i < 4; ++i) { a[i] += v0[i] * (float)gt[i]; b[i] += v1[i] * (float)gt[4 + i]; } if (!dry) { op[0] = a; op[1] = b;
                *(h16x8*)(ha + (size_t)r * DM + c) = pack8(a, b); } ss += (a[0] * a[0] + a[1] * a[1]) + (a[2] * a[2] + a[3] * a[3]) + (b[0] * b[0] + b[1] * b[1]) + (b[2] * b[2] + b[3] * b[3]); )
            ss += __shfl_xor(ss, 16); ss += __shfl_xor(ss, 32); if (fq == 0 && !dry) part[(size_t)r * 16 + u.pn * 4 + wc] = ss; )
    } };
}

struct Args { const float* in[15]; float* out; unsigned char* ws; int step_lo, step_hi, probe, pad; };
struct Grp { int B, S, M, N1; const float* x; const float* p; float* out; size_t p_lstride; };

__device__ __forceinline__ h16x8 ld8(const h16* p) { return *(const h16x8*)p; }
__device__ __forceinline__ h16x4 ld4(const h16* p) { return *(const h16x4*)p; }
__device__ __forceinline__ h16x4 tr4(const LAS unsigned char* p) { return __builtin_bit_cast(h16x4, __builtin_amdgcn_ds_read_tr16_b64_v4i16((LAS v4i16_t*)p)); }
__device__ __forceinline__ h16x8 cat8(h16x4 a, h16x4 b) { return (h16x8){a[0], a[1], a[2], a[3], b[0], b[1], b[2], b[3]}; }
__device__ __forceinline__ h16x8 pack_lo(const f32x16& v) { h16x8 o; _Pragma("unroll") for (int i = 0; i < 8; ++i) o[i] = (h16)v[i]; return o; }
__device__ __forceinline__ h16x8 pack_hi(const f32x16& v) { h16x8 o; _Pragma("unroll") for (int i = 0; i < 8; ++i) o[i] = (h16)v[8 + i]; return o; }
#define MFMA32(a, b, c) __builtin_amdgcn_mfma_f32_32x32x16_f16(a, b, c, 0, 0, 0)


#define XB_TMO      128
#define XB_XCNT(j)  (256  + 64 * (j))
#define XB_XSUB(j)  (1280 + 64 * (j))
#define XB_XGEN(j)  (2304 + 64 * (j))
#define XB_TOP      3328
#define XB_TOPGEN   3392
#define XB_SPIN_CAP (1u << 22)
__device__ __forceinline__ unsigned xb_ld(unsigned* p)              { return __hip_atomic_load(p, __ATOMIC_RELAXED, __HIP_MEMORY_SCOPE_AGENT); }
__device__ __forceinline__ unsigned xb_add(unsigned* p, unsigned v) { return __hip_atomic_fetch_add(p, v, __ATOMIC_RELAXED, __HIP_MEMORY_SCOPE_AGENT); }
__device__ __forceinline__ unsigned xb_xcc_id() { return (unsigned)__builtin_amdgcn_s_getreg((3 << 11) | 20) & 0xFu; }
#define XB_SPIN(cond, bar) do { unsigned _sp = 0; while (cond) { __builtin_amdgcn_s_sleep(1); \
    if ((++_sp & 255u) == 0u) { if (xb_ld(&(bar)[XB_TMO])) break; if (_sp > XB_SPIN_CAP) { atomicAdd(&(bar)[XB_TMO], 1u); break; } } } } while (0)
struct XcdBarrier { unsigned* bar; unsigned x; volatile LAS unsigned* st; };
__device__ __forceinline__ XcdBarrier xcd_barrier_post(unsigned* bar, volatile LAS unsigned* st) {
    XcdBarrier b; b.bar = bar; b.x = xb_xcc_id(); b.st = st;
    if (threadIdx.x == 0) (void)xb_add(&bar[XB_XCNT(b.x)], 1u);
    return b;
}
__device__ __forceinline__ void xcd_barrier_complete(unsigned* bar, unsigned x, unsigned& nloc, unsigned& nx) {
    const unsigned G = GRID;
    unsigned sum, cnt, mine, sp = 0u;
    for (;;) {
        sum = 0u; cnt = 0u; mine = 0u;
#pragma unroll
        for (unsigned j = 0; j < 16; ++j) { const unsigned c = xb_ld(&bar[XB_XCNT(j)]); sum += c; cnt += (c > 0u) ? 1u : 0u; mine = (j == x) ? c : mine; }
        if (sum == G) break;
        __builtin_amdgcn_s_sleep(1);
        if ((++sp & 255u) == 0u) { if (xb_ld(&bar[XB_TMO])) break; if (sp > XB_SPIN_CAP) { atomicAdd(&bar[XB_TMO], 1u); break; } }
    }
    nloc = mine > 0u ? mine : 1u; nx = cnt > 0u ? cnt : 1u;
}
__device__ __forceinline__ void xcd_barrier(const XcdBarrier& b) {
    asm volatile("s_waitcnt vmcnt(0)" ::: "memory");
    __syncthreads();
    if (threadIdx.x == 0) {
        unsigned* bar = b.bar;
        __builtin_amdgcn_s_waitcnt(0);
        unsigned nloc = b.st[0], nx = b.st[1];
        if (nloc == 0u) { xcd_barrier_complete(bar, b.x, nloc, nx); b.st[0] = nloc; b.st[1] = nx; }
        const unsigned old = xb_add(&bar[XB_XSUB(b.x)], 1u);
        const unsigned gen = old / nloc;
        if (old + 1u == (gen + 1u) * nloc) {
            __builtin_amdgcn_fence(__ATOMIC_RELEASE, "agent");
            asm volatile("s_waitcnt vmcnt(0)" ::: "memory");
            const unsigned og = xb_add(&bar[XB_TOP], 1u);
            const unsigned tg = og / nx;
            if (og + 1u == (tg + 1u) * nx) xb_add(&bar[XB_TOPGEN], 1u);
            else XB_SPIN(xb_ld(&bar[XB_TOPGEN]) == tg, bar);
            __builtin_amdgcn_fence(__ATOMIC_ACQUIRE, "agent");
            xb_add(&bar[XB_XGEN(b.x)], 1u);
            asm volatile("s_waitcnt vmcnt(0)" ::: "memory");
        } else {
            XB_SPIN(xb_ld(&bar[XB_XGEN(b.x)]) == gen, bar);
            __builtin_amdgcn_fence(__ATOMIC_ACQUIRE, "agent");
            asm volatile("s_waitcnt vmcnt(0)" ::: "memory");
        }
    }
    __syncthreads();
}

__device__ __forceinline__ void transpose_item(const float* W, int K, int N, h16* WT, const float* kscale, LAS float* scr, int item, int lane) {
    const int nblk = N / 32, kb = item / nblk, nb = item % nblk, k0 = 64 * kb, n0 = 32 * nb;
#pragma unroll 8
    for (int i = 0; i < 32; ++i) { const int kk = 2 * i + (lane >> 5); float v = W[(size_t)(k0 + kk) * N + n0 + (lane & 31)]; if (kscale) v *= kscale[k0 + kk]; scr[kk * 33 + (lane & 31)] = v; }
    asm volatile("s_waitcnt lgkmcnt(0)" ::: "memory");
    const int c = lane & 7;
#pragma unroll
    for (int j = 0; j < 4; ++j) { const int n = (lane >> 3) + 8 * j; const LAS float* s = scr + (8 * c) * 33 + n;
        h16x8 o; _Pragma("unroll") for (int e = 0; e < 8; ++e) o[e] = (h16)s[e * 33];
        *(h16x8*)(WT + (size_t)(n0 + n) * K + k0 + 8 * c) = o; }
    asm volatile("s_waitcnt lgkmcnt(0)" ::: "memory");
}

__device__ __forceinline__ void prologue(const Args& a, LAS unsigned char* lds) {
    int tid_ = threadIdx.x; asm volatile("" : "+v"(tid_));
    const int tid = tid_, lane = tid & 63, wave = tid >> 6;
    const int gw = blockIdx.x * 8 + wave, NGW = GRID * 8;
    LAS float* scr = (LAS float*)(lds + wave * 16384);
    h16* Wb = (h16*)(a.ws + WS_W);
    constexpr int I_IN = (DM / 64) * (ZW / 32), I_AO = (512 / 64) * (DM / 32), I_OUT = (DM / 64) * (DM / 32), I_PE = (PLE / 64) * (DM / 32), I_FM = 4 * (128 / 64) * (128 / 32);
    constexpr int I_L = I_IN + 2 * I_AO + 2 * I_OUT + I_PE + I_FM;
#pragma unroll 1
    for (int it = gw; it < DEPTH * I_L; it += NGW) {
        const int l = it / I_L; int r = it % I_L; h16* wl = Wb + (size_t)l * LW_SZ;
        if (r < I_IN) { transpose_item(a.in[5] + (size_t)l * DM * ZW, DM, ZW, wl + LW_IN, a.in[4] + l * DM, scr, r, lane); continue; } r -= I_IN;
        if (r < I_AO) { transpose_item(a.in[8] + (size_t)l * 512 * DM, 512, DM, wl + LW_AO, nullptr, scr, r, lane); continue; } r -= I_AO;
        if (r < I_AO) { transpose_item(a.in[9] + (size_t)l * 512 * DM, 512, DM, wl + LW_FO, nullptr, scr, r, lane); continue; } r -= I_AO;
        if (r < I_OUT) { transpose_item(a.in[10] + (size_t)l * DM * DM, DM, DM, wl + LW_OUT, nullptr, scr, r, lane); continue; } r -= I_OUT;
        if (r < I_OUT) { transpose_item(a.in[13] + (size_t)l * DM * DM, DM, DM, wl + LW_PG, a.in[12] + l * DM, scr, r, lane); continue; } r -= I_OUT;
        if (r < I_PE) { transpose_item(a.in[11] + (size_t)l * PLE * DM, PLE, DM, wl + LW_PE, nullptr, scr, r, lane); continue; } r -= I_PE;
        { const int g = r / 8, rr = r % 8; transpose_item(a.in[7] + ((size_t)l * 4 + g) * 128 * 128, 128, 128, wl + LW_FM + (size_t)g * 128 * 128, nullptr, scr, rr, lane); }
    }
    const int gt = blockIdx.x * 512 + tid, NGT = GRID * 512;
    const float invf[8] = {1.0f, 0.19392274f, 0.03760603f, 0.0072926646f, 0.0014142136f, 0.0002742482f, 5.3182957e-05f, 1.0313385e-05f};
    f32x2* rope = (f32x2*)(a.ws + WS_ROPE);
#pragma unroll 1
    for (int i = gt; i < 8192 * 8; i += NGT) { const int pos = i >> 3, j = i & 7;
        float fq = 1.0f; _Pragma("unroll") for (int q = 0; q < 8; ++q) if (j == q) fq = invf[q];
        const float ang = (float)pos * fq; double rev = (double)ang * 0.15915494309189535; rev -= rint(rev);
        float s, c; sincospif((float)(2.0 * rev), &s, &c); rope[i] = (f32x2){c, s}; }
    h16* t1a = (h16*)(a.ws + WS_T1A);
#pragma unroll 1
    for (int i = gt; i < 256 * 128; i += NGT) { const int n = i >> 7, c = i & 127, d = n & 127; float s, co; sincospif((float)((d * c) & 127) * (2.0f / 128.0f), &s, &co);
        t1a[i] = (h16)((n < 128 ? co : -s) * 0.08838834764831845f); }
    {   h16* t = (h16*)(a.ws + WS_T1B64);
#pragma unroll 1
        for (int i = gt; i < 128 * 128; i += NGT) { const int row = i >> 7, col = i & 127, k1 = row & 63, s1 = col & 63; float s, co; sincospif((float)((k1 * s1) & 63) * (2.0f / 64.0f), &s, &co);
            const float v = (row < 64) ? (col < 64 ? co : s) : (col < 64 ? -s : co); t[i] = (h16)(v * 0.125f); } }
    {   h16* t = (h16*)(a.ws + WS_T1B128);
#pragma unroll 1
        for (int i = gt; i < 256 * 256; i += NGT) { const int row = i >> 8, col = i & 255, k1 = row & 127, s1 = col & 127; float s, co; sincospif((float)((k1 * s1) & 127) * (2.0f / 128.0f), &s, &co);
            const float v = (row < 128) ? (col < 128 ? co : s) : (col < 128 ? -s : co); t[i] = (h16)(v * 0.08838834764831845f); } }
    {   h16* t = (h16*)(a.ws + WS_T2);
#pragma unroll 1
        for (int i = gt; i < 64 * 128; i += NGT) { const int k2 = i >> 7, col = i & 127, s2 = col & 63; float s, co; sincospif((float)((k2 * s2) & 63) * (2.0f / 64.0f), &s, &co);
            t[i] = (h16)((col < 64 ? co : s) * 0.125f); } }
    {   f32x2* t = (f32x2*)(a.ws + WS_TW64);
#pragma unroll 1
        for (int i = gt; i < 64 * 64; i += NGT) { const int k1 = i >> 6, s2 = i & 63; float s, co; sincospif((float)(k1 * s2) * (2.0f / 4096.0f), &s, &co); t[i] = (f32x2){co, s}; } }
    {   f32x2* t = (f32x2*)(a.ws + WS_TW128);
#pragma unroll 1
        for (int i = gt; i < 128 * 64; i += NGT) { const int k1 = i >> 6, s2 = i & 63; float s, co; sincospif((float)(k1 * s2) * (2.0f / 8192.0f), &s, &co); t[i] = (f32x2){co, s}; } }
}

__device__ __forceinline__ void group_start(const Grp& G, h16* ha, float* part2) {
    int tid_ = threadIdx.x; asm volatile("" : "+v"(tid_));
    const int lane = tid_ & 63, gw = blockIdx.x * 8 + (tid_ >> 6), NGW = GRID * 8;
#pragma unroll 1
    for (int r = gw; r < G.M; r += NGW) {
        const f32x4* xr = (const f32x4*)(G.x + (size_t)r * DM) + lane; float ss = 0.f;
#pragma unroll
        for (int j = 0; j < 4; ++j) { const f32x4 v = xr[64 * j]; ss += (v[0] * v[0] + v[1] * v[1]) + (v[2] * v[2] + v[3] * v[3]);
            h16x4 o = {(h16)v[0], (h16)v[1], (h16)v[2], (h16)v[3]}; *((h16x4*)(ha + (size_t)r * DM) + lane + 64 * j) = o; }
#pragma unroll
        for (int o = 1; o < 64; o <<= 1) ss += __shfl_xor(ss, o);
        if (lane < 16) part2[(size_t)r * 16 + lane] = (lane == 0) ? ss : 0.f;
    }
}
__device__ __forceinline__ void convert_p(const Grp& G, int layer, h16* p16) {
    const f32x4* src = (const f32x4*)(G.p + (size_t)layer * G.p_lstride); const size_t n4 = (size_t)G.M * PLE / 4;
    int tid_ = threadIdx.x; asm volatile("" : "+v"(tid_));
#pragma unroll 1
    for (size_t i = (size_t)blockIdx.x * 512 + tid_; i < n4; i += (size_t)GRID * 512) { const f32x4 v = src[i]; h16x4 o = {(h16)v[0], (h16)v[1], (h16)v[2], (h16)v[3]}; ((h16x4*)p16)[i] = o; }
}
__device__ __forceinline__ void final_norm(const Grp& G, const float* part2, const float* lnf) {
    int tid_ = threadIdx.x; asm volatile("" : "+v"(tid_));
    const int lane = tid_ & 63, gw = blockIdx.x * 8 + (tid_ >> 6), NGW = GRID * 8;
#pragma unroll 1
    for (int r = gw; r < G.M; r += NGW) {
        const float rs = pg8::rstd_from(part2, r);
        f32x4* xr = (f32x4*)(G.out + (size_t)r * DM) + lane;
#pragma unroll
        for (int j = 0; j < 4; ++j) { const f32x4 w = ((const f32x4*)lnf)[lane + 64 * j]; xr[64 * j] = xr[64 * j] * rs * w; }
    }
}

constexpr int KS_STRIDE = 144, VS_STRIDE = 192, KS_BYTES = 384 * KS_STRIDE;
__device__ __forceinline__ void attn_unit(LAS unsigned char* lds, h16* z, h16* obase, int ostride, const f32x2* rope, const float* sink, int S, int b, int nb, int g) {
    int tid_ = threadIdx.x; asm volatile("" : "+v"(tid_));
    const int tid = tid_, lane = tid & 63, wid = tid >> 6, l31 = lane & 31, hi = lane >> 5;
    LAS unsigned char* Ks = lds; LAS unsigned char* Vs = lds + KS_BYTES;
    const int kb0 = nb * 128 - 128;
    const size_t rowbase = (size_t)b * S;
#pragma unroll
    for (int i = 0; i < 3; ++i) { const int item = tid + 512 * i, kk = item >> 2, c4 = item & 3, pos = kb0 + kk;
        h16x8 v0 = {}, v1 = {};
        if (pos >= 0 && pos < S) { const h16* src = z + (rowbase + pos) * ZW + C_K + g * 64 + c4 * 16; v0 = ld8(src); v1 = ld8(src + 8);
            if (c4 == 0) { const f32x2* rp = rope + (size_t)pos * 8; h16x8 o0, o1;
                _Pragma("unroll") for (int j = 0; j < 8; ++j) { const f32x2 cs = rp[j]; const float x1 = (float)v0[j], x2 = (float)v1[j]; o0[j] = (h16)(x1 * cs[0] - x2 * cs[1]); o1[j] = (h16)(x2 * cs[0] + x1 * cs[1]); }
                v0 = o0; v1 = o1; } }
        *(LAS h16x8*)(Ks + kk * KS_STRIDE + c4 * 32) = v0; *(LAS h16x8*)(Ks + kk * KS_STRIDE + c4 * 32 + 16) = v1; }
#pragma unroll
    for (int i = 0; i < 6; ++i) { const int item = tid + 512 * i, kk = item >> 3, c8 = item & 7, pos = kb0 + kk;
        h16x8 v = {}; if (pos >= 0 && pos < S) v = ld8(z + (rowbase + pos) * ZW + C_V + g * 64 + c8 * 8);
        *(LAS h16x8*)(Vs + kk * VS_STRIDE + c8 * 16) = v; }
    __syncthreads();
    const float CS = 0.125f * 1.44269504089f;
    const bool edge_block = (nb == 0) || (nb == S / 128 - 1);
    const int blk = (lane >> 4) & 1, q4 = (lane & 15) >> 2, p4 = lane & 3;
#pragma unroll 1
    for (int it = 0; it < 2; ++it) {
        const int item = wid + 8 * it, hh = item >> 2, rg = item & 3, head = g * 4 + hh;
        const int qi = nb * 128 + rg * 32 + l31;
        h16* qrow = z + (rowbase + qi) * ZW + C_Q + head * 64;
        h16x8 qf[4];
        {   const h16x8 a0 = ld8(qrow), a1 = ld8(qrow + 8); const f32x2* rp = rope + (size_t)qi * 8; h16x8 o;
            _Pragma("unroll") for (int j = 0; j < 8; ++j) { const f32x2 cs = rp[j]; const float x1 = (float)a0[j], x2 = (float)a1[j]; o[j] = hi ? (h16)(x2 * cs[0] + x1 * cs[1]) : (h16)(x1 * cs[0] - x2 * cs[1]); }
            qf[0] = o; }
#pragma unroll
        for (int ks = 1; ks < 4; ++ks) qf[ks] = ld8(qrow + 16 * ks + 8 * hi);
        const float sk = sink[head] * 1.44269504089f;
        float mrun = sk, lrun = hi ? 0.f : 1.f;
        f32x16 o0 = {}, o1 = {};
#pragma unroll 1
        for (int tt = 0; tt < 9; ++tt) {
            const int t = rg + tt;
            f32x16 st = {};
            const LAS unsigned char* kp = Ks + (32 * t + l31) * KS_STRIDE + hi * 16;
#pragma unroll
            for (int ks = 0; ks < 4; ++ks) st = MFMA32(*(const LAS h16x8*)(kp + ks * 32), qf[ks], st);
            const bool need_mask = edge_block || tt == 0 || tt == 8;
            float mx = -3.0e38f;
#pragma unroll
            for (int j = 0; j < 16; ++j) { float s = st[j] * CS;
                if (need_mask) { const int pos = kb0 + 32 * t + (j & 3) + 8 * (j >> 2) + 4 * hi; const int rel = pos - qi; const bool ok = (pos >= 0) && (pos < S) && (rel <= 128) && (rel >= -128); s = ok ? s : -1.0e30f; }
                st[j] = s; mx = fmaxf(mx, s); }
            mx = fmaxf(mx, __shfl_xor(mx, 32));
            const float mnew = fmaxf(mrun, mx), alpha = __builtin_amdgcn_exp2f(mrun - mnew);
            mrun = mnew; float ps = 0.f;
#pragma unroll
            for (int j = 0; j < 16; ++j) { const float p = __builtin_amdgcn_exp2f(st[j] - mnew); st[j] = p; ps += p; }
            lrun = lrun * alpha + ps;
#pragma unroll
            for (int j = 0; j < 16; ++j) { o0[j] *= alpha; o1[j] *= alpha; }
            const h16x8 pk0 = pack_lo(st), pk1 = pack_hi(st);
            const LAS unsigned char* vp = Vs + (32 * t + 4 * hi + q4) * VS_STRIDE + (16 * blk + 4 * p4) * 2;
#pragma unroll
            for (int u = 0; u < 2; ++u) {
                const h16x8 va0 = cat8(tr4(vp + (16 * u) * VS_STRIDE), tr4(vp + (16 * u + 8) * VS_STRIDE));
                const h16x8 va1 = cat8(tr4(vp + (16 * u) * VS_STRIDE + 64), tr4(vp + (16 * u + 8) * VS_STRIDE + 64));
                o0 = MFMA32(va0, u ? pk1 : pk0, o0); o1 = MFMA32(va1, u ? pk1 : pk0, o1);
            }
        }
        const float ltot = lrun + __shfl_xor(lrun, 32), inv = 1.0f / ltot;
        const h16* garow = z + (rowbase + qi) * ZW + C_GA + head * 64;
#pragma unroll
        for (int mb = 0; mb < 2; ++mb)
#pragma unroll
            for (int jg = 0; jg < 4; ++jg) { const int d = 32 * mb + 8 * jg + 4 * hi; const h16x4 gv = ld4(garow + d); h16x4 o;
                _Pragma("unroll") for (int e = 0; e < 4; ++e) { const float ga = (float)gv[e]; const float ov = (mb ? o1[4 * jg + e] : o0[4 * jg + e]) * inv; o[e] = (h16)(ov * ga * sigm(ga)); }
                *(h16x4*)(obase + (rowbase + qi) * ostride + head * 64 + d) = o; }
    }
    __syncthreads();
}

template <int N1>
__device__ __forceinline__ void f1_unit(LAS unsigned char* lds, const h16* z, h16* Gb, const h16* t1a, const h16* t1b, const f32x2* tw, int S, int b, int s2) {
    constexpr int US = 1040, NRB = N1 / 32;
    int tid_ = threadIdx.x; asm volatile("" : "+v"(tid_));
    const int tid = tid_, lane = tid & 63, wid = tid >> 6, l31 = lane & 31, hi = lane >> 5;
    const size_t rowbase = (size_t)b * S;
#pragma unroll
    for (int i = 0; i < N1 / 8; ++i) { const int item = tid + 512 * i, s1 = item >> 6, ch = item & 63;
        *(LAS h16x8*)(lds + s1 * US + ch * 16) = ld8(z + (rowbase + 64 * s1 + s2) * ZW + C_UF + ch * 8); }
    __syncthreads();
#pragma unroll 1
    for (int dbi = 0; dbi < 2; ++dbi) {
        const int db = wid * 2 + dbi, g = db >> 2, dq = db & 3;
        h16x8 Xs[2][NRB][2];
#pragma unroll
        for (int part = 0; part < 2; ++part) {
            h16x8 bf[8];
#pragma unroll
            for (int ks = 0; ks < 8; ++ks) bf[ks] = ld8(t1a + (size_t)(part * 128 + dq * 32 + l31) * 128 + 16 * ks + 8 * hi);
#pragma unroll
            for (int rb = 0; rb < NRB; ++rb) { f32x16 acc = {};
                const LAS unsigned char* up = lds + (rb * 32 + l31) * US + (g * 128 + 8 * hi) * 2;
#pragma unroll
                for (int ks = 0; ks < 8; ++ks) acc = MFMA32(*(const LAS h16x8*)(up + ks * 32), bf[ks], acc);
                Xs[part][rb][0] = pack_lo(acc); Xs[part][rb][1] = pack_hi(acc); }
        }
#pragma unroll 1
        for (int kb = 0; kb < NRB; ++kb) {
            f32x16 aR = {}, aI = {};
            const h16* wR = t1b + (size_t)(kb * 32 + l31) * (2 * N1) + 4 * hi; const h16* wI = wR + (size_t)N1 * (2 * N1);
#pragma unroll
            for (int part = 0; part < 2; ++part)
#pragma unroll
                for (int rb = 0; rb < NRB; ++rb)
#pragma unroll
                    for (int t = 0; t < 2; ++t) { const int co = part * N1 + rb * 32 + 16 * t;
                        aR = MFMA32(Xs[part][rb][t], cat8(ld4(wR + co), ld4(wR + co + 8)), aR);
                        aI = MFMA32(Xs[part][rb][t], cat8(ld4(wI + co), ld4(wI + co + 8)), aI);
                        if (N1 == 128 && t == 1) __builtin_amdgcn_sched_barrier(0); }
            const int k1 = kb * 32 + l31; const f32x2 cs = tw[k1 * 64 + s2];
            h16* grow = Gb + (rowbase + (size_t)k1 * 64 + s2) * 1024 + g * 256 + dq * 32 + 4 * hi;
#pragma unroll
            for (int jg = 0; jg < 4; ++jg) { h16x4 orr, oi;
                _Pragma("unroll") for (int e = 0; e < 4; ++e) { const float gr = aR[4 * jg + e], gi = aI[4 * jg + e]; orr[e] = (h16)(gr * cs[0] + gi * cs[1]); oi[e] = (h16)(gi * cs[0] - gr * cs[1]); }
                *(h16x4*)(grow + 8 * jg) = orr; *(h16x4*)(grow + 128 + 8 * jg) = oi; }
        }
    }
    __syncthreads();
}

__device__ __forceinline__ void f2_unit(LAS unsigned char* lds, h16* z, const h16* Gb, const h16* wfm, const h16x8 (&bt2)[8], int S, int N1, int b, int k1) {
    constexpr int GS = 2112;
    int tid_ = threadIdx.x; asm volatile("" : "+v"(tid_));
    const int tid = tid_, lane = tid & 63, wid = tid >> 6, l31 = lane & 31, hi = lane >> 5;
    const int blk = (lane >> 4) & 1, q4 = (lane & 15) >> 2, p4 = lane & 3;
    const size_t rowbase = (size_t)b * S;
    const h16* gsrc = Gb + (rowbase + (size_t)k1 * 64) * 1024;
#pragma unroll
    for (int i = 0; i < 16; ++i) { const int item = tid + 512 * i, s2 = item >> 7, ch = item & 127;
        *(LAS h16x8*)(lds + s2 * GS + ch * 16) = ld8(gsrc + (size_t)s2 * 1024 + ch * 8); }
    __syncthreads();
    const int g = wid >> 1, kb2 = wid & 1;
    h16x8 Ys[4][2];
#pragma unroll
    for (int db = 0; db < 4; ++db) { f32x16 acc = {};
#pragma unroll
        for (int kk = 0; kk < 8; ++kk) { const int part = kk >> 2, ks = kk & 3;
            const LAS unsigned char* ap = lds + (16 * ks + 8 * hi + q4) * GS + (g * 256 + part * 128 + 32 * db + 16 * blk + 4 * p4) * 2;
            acc = MFMA32(cat8(tr4(ap), tr4(ap + 4 * GS)), bt2[kk], acc); }
        Ys[db][0] = pack_lo(acc); Ys[db][1] = pack_hi(acc); }
    const int k2 = kb2 * 32 + l31; const size_t trow = rowbase + k1 + (size_t)N1 * k2;
    const h16* gfrow = z + trow * ZW + C_GF + g * 128; h16* frow = z + trow * ZW + C_UF + g * 128;
    const h16* wg = wfm + (size_t)g * 128 * 128;
#pragma unroll 1
    for (int ob = 0; ob < 4; ++ob) { f32x16 acc = {};
        const h16* wr = wg + (size_t)(ob * 32 + l31) * 128 + 4 * hi;
#pragma unroll
        for (int db = 0; db < 4; ++db)
#pragma unroll
            for (int t = 0; t < 2; ++t) { const int co = 32 * db + 16 * t; acc = MFMA32(cat8(ld4(wr + co), ld4(wr + co + 8)), Ys[db][t], acc); }
#pragma unroll
        for (int jg = 0; jg < 4; ++jg) { const int d = 32 * ob + 8 * jg + 4 * hi; const h16x4 gv = ld4(gfrow + d); h16x4 o;
            _Pragma("unroll") for (int e = 0; e < 4; ++e) { const float gf = (float)gv[e]; o[e] = (h16)(acc[4 * jg + e] * gf * sigm(gf)); }
            *(h16x4*)(frow + d) = o; }
    }
    __syncthreads();
}

#ifndef PHM
#define PHM 0xFFFF
#endif
#ifndef PROBE_MASK
#define PROBE_MASK 0
#endif
constexpr int STEPS_PER_GROUP = 2 + DEPTH * 6;
constexpr int N_STEPS = 1 + 2 * STEPS_PER_GROUP;

__global__ void __launch_bounds__(512, 2) fwd_megakernel(Args args) {
    extern __shared__ __attribute__((aligned(16))) unsigned char lds_raw[];
    LAS unsigned char* lds = (LAS unsigned char*)lds_raw;
    cg::grid_group grid = cg::this_grid();
    unsigned char* ws = args.ws;
    h16* z = (h16*)(ws + WS_Z); h16* Gb = (h16*)(ws + WS_G); h16* ha = (h16*)(ws + WS_HA); h16* p16 = (h16*)(ws + WS_P16);
    float* part1 = (float*)(ws + WS_PART1); float* part2 = (float*)(ws + WS_PART2);
    const h16* Wb = (const h16*)(ws + WS_W);
    const f32x2* rope = (const f32x2*)(ws + WS_ROPE);
    const int Gsz = GRID, cid = blockIdx.x;
    volatile LAS unsigned* bst = (volatile LAS unsigned*)(lds + LDS_CTL_OFF);
    if (threadIdx.x < 16) bst[threadIdx.x] = 0u;
    __syncthreads();
    const XcdBarrier xbar = xcd_barrier_post((unsigned*)(ws + WS_BAR), bst);

    for (int step = args.step_lo; step < args.step_hi; ++step) {
        if (step > args.step_lo) { if (step == 1) grid.sync(); else xcd_barrier(xbar); if (args.probe & 128) xcd_barrier(xbar); }
        if (step == 0) { if (PHM & 256) prologue(args, lds); __syncthreads(); continue; }
        const int gi = (step - 1) / STEPS_PER_GROUP, ls = (step - 1) % STEPS_PER_GROUP;
        Grp G;
        if (gi == 0) { G.B = 16; G.S = 4096; G.N1 = 64; G.x = args.in[0]; G.p = args.in[2]; G.out = args.out; G.p_lstride = (size_t)16 * 4096 * PLE; }
        else { G.B = 4; G.S = 8192; G.N1 = 128; G.x = args.in[1]; G.p = args.in[3]; G.out = args.out + (size_t)16 * 4096 * DM; G.p_lstride = (size_t)4 * 8192 * PLE; }
        G.M = G.B * G.S;
        if (ls == 0) { if (PHM & 512) group_start(G, ha, part2); continue; }
        if (ls == STEPS_PER_GROUP - 1) { if (PHM & 1024) final_norm(G, part2, args.in[14]); continue; }
        const int layer = (ls - 1) / 6, ph = (ls - 1) % 6;
        const h16* wl = Wb + (size_t)layer * LW_SZ;
        pg8::StaticOrder<ZW / 256> SOA; pg8::StaticOrder<DM / 256> SO;
        const int pb = args.probe;
        if (ph == 0 && (PHM & 1)) {
            pg8::Gemm gm{ha, DM, wl + LW_IN, G.M, ZW, DM}; SOA.init(G.M, Gsz, cid);
            const int nrep = (pb & 1) ? 2 : 1;
            for (int rep = 0; rep < nrep; ++rep) { pg8::EpiZ E{z, part2, rep < nrep - 1}; pg8::gemm_phase(lds, gm, SOA, E); }
        } else if (ph == 1 && (PHM & 2)) {
            const int nblk = G.S / 128, lgb = (G.S == 4096) ? 5 : 6, nA = G.B * nblk * 2;
            const float* sink = args.in[6] + layer * 8;
            if (pb & 2) for (int u = cid; u < nA; u += Gsz) { const int g = u & 1, nb = (u >> 1) & (nblk - 1), b = (u >> 1) >> lgb; attn_unit(lds, z, Gb, 1024, rope, sink, G.S, b, nb, g); }
            if (PHM & 64) for (int u = cid; u < nA; u += Gsz) { const int g = u & 1, nb = (u >> 1) & (nblk - 1), b = (u >> 1) >> lgb; attn_unit(lds, z, z, ZW, rope, sink, G.S, b, nb, g); }
            const int nF = G.B * 64;
            const h16* t1a = (const h16*)(ws + WS_T1A);
            const int nrep = (pb & 4) ? 2 : 1;
            for (int rep = 0; rep < nrep; ++rep) {
            if (G.N1 == 64 && (PHM & 128)) { const h16* t1b = (const h16*)(ws + WS_T1B64); const f32x2* tw = (const f32x2*)(ws + WS_TW64);
                for (int u = cid; u < nF; u += Gsz) f1_unit<64>(lds, z, Gb, t1a, t1b, tw, G.S, u >> 6, u & 63); }
            else if (PHM & 2048) { const h16* t1b = (const h16*)(ws + WS_T1B128); const f32x2* tw = (const f32x2*)(ws + WS_TW128);
                for (int u = cid; u < nF; u += Gsz) f1_unit<128>(lds, z, Gb, t1a, t1b, tw, G.S, u >> 6, u & 63); }
            }
        } else if (ph == 2 && (PHM & 4)) {
            convert_p(G, layer, p16);
            const h16* t2 = (const h16*)(ws + WS_T2);
            int tid_ = threadIdx.x; asm volatile("" : "+v"(tid_));
            const int lane = tid_ & 63, wid = tid_ >> 6, kb2 = wid & 1;
            h16x8 bt2[8];
#pragma unroll
            for (int kk = 0; kk < 8; ++kk) bt2[kk] = ld8(t2 + (size_t)(kb2 * 32 + (lane & 31)) * 128 + (kk >> 2) * 64 + 16 * (kk & 3) + 8 * (lane >> 5));
            const int nU = G.B * G.N1;
            const int nrep = (pb & 8) ? 2 : 1;
            for (int rep = 0; rep < nrep; ++rep)
            for (int u = cid; u < nU; u += Gsz) f2_unit(lds, z, Gb, wl + LW_FM, bt2, G.S, G.N1, u >> (G.N1 == 64 ? 6 : 7), u & (G.N1 - 1));
        } else if (ph == 3 && (PHM & 8)) {
            SO.init(G.M, Gsz, cid);
            const int nrep = (pb & 16) ? 2 : 1;
            for (int rep = 0; rep < nrep; ++rep) { const bool dry = rep < nrep - 1;
            { pg8::Gemm gm{z + C_Q, ZW, wl + LW_AO, G.M, DM, 512}; pg8::EpiD1 E{z, dry}; pg8::gemm_phase(lds, gm, SO, E); }
            { pg8::Gemm gm{z + C_UF, ZW, wl + LW_FO, G.M, DM, 512}; pg8::EpiD2 E{z, dry}; pg8::gemm_phase(lds, gm, SO, E); } }
        } else if (ph == 4 && (PHM & 16)) {
            SO.init(G.M, Gsz, cid);
            const int nrep = (pb & 32) ? 2 : 1;
            for (int rep = 0; rep < nrep; ++rep) {
            pg8::Gemm gm{z + C_MGA, ZW, wl + LW_OUT, G.M, DM, DM}; pg8::EpiE E{layer == 0 ? G.x : (const float*)G.out, G.out, z, part1, rep < nrep - 1}; pg8::gemm_phase(lds, gm, SO, E); }
        } else if (ph == 5 && (PHM & 32)) {
            SO.init(G.M, Gsz, cid);
            const int nrep = (pb & 64) ? 2 : 1;
            for (int rep = 0; rep < nrep; ++rep) { const bool dry = rep < nrep - 1;
            { pg8::Gemm gm{z + C_MGF, ZW, wl + LW_PG, G.M, DM, DM}; pg8::EpiF1 E{z, part1, dry}; pg8::gemm_phase(lds, gm, SO, E); }
            { pg8::Gemm gm{p16, PLE, wl + LW_PE, G.M, DM, PLE}; pg8::EpiF2 E{G.out, z, ha, part2, dry}; pg8::gemm_phase(lds, gm, SO, E); } }
        }
    }
}

extern "C" void kernel_launch(void* const* d_in, const int* in_sizes, int n_in, void* d_out, int out_size, void* d_ws, size_t ws_size, hipStream_t stream) {
    static int grid = 0;
    if (grid == 0) {
        if (n_in != 15 || ws_size < WS_END) { fprintf(stderr, "kernel_launch: need 15 inputs and %zu bytes of workspace (got %d, %zu)\n", (size_t)WS_END, n_in, ws_size); grid = -1; return; }
        int dev = 0, cus = 0, per_cu = 0;
        (void)hipGetDevice(&dev); (void)hipDeviceGetAttribute(&cus, hipDeviceAttributeMultiprocessorCount, dev);
        if (hipFuncSetAttribute((const void*)fwd_megakernel, hipFuncAttributeMaxDynamicSharedMemorySize, LDS_BYTES) != hipSuccess) { fprintf(stderr, "kernel_launch: hipFuncSetAttribute failed\n"); grid = -1; return; }
        if (hipOccupancyMaxActiveBlocksPerMultiprocessor(&per_cu, (const void*)fwd_megakernel, 512, LDS_BYTES) != hipSuccess || per_cu < 1) { fprintf(stderr, "kernel_launch: occupancy query says %d\n", per_cu); per_cu = 1; }
        (void)hipGetLastError();
        if (cus < GRID) { fprintf(stderr, "kernel_launch: built for %d CUs, device has %d\n", GRID, cus); grid = -1; return; }
        grid = GRID;
    }
    if (grid < 0) return;
    Args a{};
    for (int i = 0; i < 15; ++i) a.in[i] = (const float*)d_in[i];
    a.out = (float*)d_out; a.ws = (unsigned char*)d_ws; a.step_lo = 0; a.step_hi = N_STEPS; a.probe = PROBE_MASK;
    if (hipMemsetAsync((char*)d_ws + WS_BAR, 0, WS_BAR_BYTES, stream) != hipSuccess) { fprintf(stderr, "kernel_launch: memset failed\n"); return; }
    void* kargs[] = {&a};
    hipError_t e = hipLaunchCooperativeKernel((const void*)fwd_megakernel, dim3(grid), dim3(512), kargs, LDS_BYTES, stream);
    if (e != hipSuccess) fprintf(stderr, "kernel_launch: cooperative launch failed: %s (grid %d)\n", hipGetErrorString(e), grid);
}
```

```cpp
#include <hip/hip_runtime.h>
#include <hip/hip_cooperative_groups.h>
#include <cstdio>
#include <cstdint>
namespace cg = cooperative_groups;

#define LAS __attribute__((address_space(3)))
typedef _Float16 h16;
typedef _Float16 h16x8 __attribute__((ext_vector_type(8)));
typedef _Float16 h16x4 __attribute__((ext_vector_type(4)));
typedef _Float16 h16x2 __attribute__((ext_vector_type(2)));
typedef float f32x4 __attribute__((ext_vector_type(4)));
typedef float f32x2 __attribute__((ext_vector_type(2)));
typedef float f32x16 __attribute__((ext_vector_type(16)));
typedef short v4i16_t __attribute__((ext_vector_type(4)));

constexpr int DM = 1024, DEPTH = 4, ZW = 4352, PLE = 256;
constexpr int C_Q = 0, C_K = 512, C_V = 640, C_GA = 768, C_UF = 1280, C_GF = 1792, C_MGA = 2304, C_MGF = 3328;
constexpr int MG_MAX = 65536;
constexpr float EPS = 1e-6f;
constexpr size_t LW_IN = 0, LW_AO = LW_IN + (size_t)ZW * DM, LW_FO = LW_AO + (size_t)DM * 512, LW_OUT = LW_FO + (size_t)DM * 512,
                 LW_PG = LW_OUT + (size_t)DM * DM, LW_PE = LW_PG + (size_t)DM * DM, LW_FM = LW_PE + (size_t)DM * PLE, LW_SZ = LW_FM + 4 * 128 * 128;
constexpr size_t WS_Z = 0;
constexpr size_t WS_G = WS_Z + (size_t)MG_MAX * ZW * 2;
constexpr size_t WS_HA = WS_G + (size_t)MG_MAX * 2048;
constexpr size_t WS_P16 = WS_HA + (size_t)MG_MAX * 2048;
constexpr size_t WS_PART1 = WS_P16 + (size_t)MG_MAX * 512;
constexpr size_t WS_PART2 = WS_PART1 + (size_t)MG_MAX * 64;
constexpr size_t WS_W = WS_PART2 + (size_t)MG_MAX * 64;
constexpr size_t WS_ROPE = WS_W + (size_t)DEPTH * LW_SZ * 2;
constexpr size_t WS_T1A = WS_ROPE + 8192 * 8 * 8;
constexpr size_t WS_T1B64 = WS_T1A + 256 * 128 * 2;
constexpr size_t WS_T1B128 = WS_T1B64 + 128 * 128 * 2;
constexpr size_t WS_T2 = WS_T1B128 + 256 * 256 * 2;
constexpr size_t WS_TW64 = WS_T2 + 64 * 128 * 2;
constexpr size_t WS_TW128 = WS_TW64 + 64 * 64 * 8;
constexpr size_t WS_BAR = WS_TW128 + 128 * 64 * 8;
constexpr size_t WS_BAR_BYTES = 16384;
constexpr size_t WS_END = WS_BAR + WS_BAR_BYTES;

constexpr int GRID = 256;
constexpr int LDS_CTL_OFF = 139264;
constexpr int LDS_BYTES = 139264 + 64;

__device__ __forceinline__ float sigm(float x) { return __builtin_amdgcn_rcpf(1.0f + __builtin_amdgcn_exp2f(-1.44269504089f * x)); }

namespace pg8 {
constexpr int BM = 256, BK = 64, HALF = 128, HTB = HALF * BK * 2, NXCD = 8, WGM = 8;
__device__ __forceinline__ int lds_byte(int r, int c) { const int st = (r >> 4) * 2 + (c >> 5), rr = r & 15, cc = c & 31, ob = rr * 64 + cc * 2; return st * 1024 + (ob ^ (((ob >> 9) & 1) << 5)); }
__device__ __forceinline__ void stage_rc(int b, int& R, int& C) { const int st = b / 1024, sb = b % 1024, swz = sb ^ (((sb >> 9) & 1) << 5); R = (st >> 1) * 16 + swz / 64; C = (st & 1) * 32 + (swz % 64) / 2; }
__device__ __forceinline__ int perm32(int rho) { const int n = rho >> 4, i = rho & 15; return 8 * (i >> 2) + 4 * n + (i & 3); }
struct Unit { int pm, pn; };
struct Gemm { const h16* A; int lda; const h16* Bt; int M, N, K; };
template <int NN> struct StaticOrder {
    int nwg, G, c;
    __device__ void init(int M, int G_, int c_) { nwg = (M / BM) * NN; G = G_; c = c_; }
    __device__ bool next(int i, Unit& u) const {
        const long L = (long)i * G + c; if (L >= nwg) return false;
        int wgid = (int)L; { const int q = nwg / NXCD, r = nwg % NXCD, xcd = wgid % NXCD, off = wgid / NXCD; wgid = (xcd < r ? xcd * (q + 1) : r * (q + 1) + (xcd - r) * q) + off; }
        constexpr int nig = WGM * NN; const int gid = wgid / nig, fm = gid * WGM;
        u.pm = fm + ((wgid % nig) % WGM); u.pn = (wgid % nig) / WGM; return true;
    }
};
typedef f32x4 Acc[2][2][4][2];

template <class Epi, class Sched>
__device__ __forceinline__ void gemm_phase(LAS unsigned char* lds, const Gemm g, const Sched& S, const Epi& E) {
    int tid_ = threadIdx.x; asm volatile("" : "+v"(tid_));
    const int tid = tid_, wid = __builtin_amdgcn_readfirstlane(tid >> 6), lane = tid & 63, wr = wid >> 2, wc = wid & 3, fr = lane & 15, fq = lane >> 4;
    const int K = g.K, nt = K / BK;
    unsigned voffA[2], voffB[2];
#pragma unroll
    for (int i = 0; i < 2; ++i) { int R, C; stage_rc(tid * 16 + i * 8192, R, C); const int Rb = (R & ~31) + perm32(R & 31);
        voffA[i] = (unsigned)(R * g.lda + C) * 2u; voffB[i] = (unsigned)(Rb * K + C) * 2u; }
    const size_t kstep = (size_t)(BK * 2);
    const size_t hstepA = (size_t)HALF * g.lda * 2, tstepA = 2 * hstepA;
    const size_t hstepB = (size_t)HALF * K * 2, tstepB = 2 * hstepB;
    const unsigned ldsw = (unsigned)wid * 1024u;
    const int aoff = lds_byte(wr * 64 + fr, fq * 8), boff = lds_byte(wc * 32 + fr, fq * 8);
#define PG8_SA(b, h) (((b) * 2 + (h)) * HTB)
#define PG8_SB(b, h) ((4 + (b) * 2 + (h)) * HTB)
#define PG8_STAGE(bufoff, gbase, voff) do { _Pragma("unroll") for (int _i = 0; _i < 2; ++_i) \
        __builtin_amdgcn_global_load_lds((const unsigned*)((const char*)(gbase) + (voff)[_i]), (LAS unsigned*)(lds + (bufoff) + ldsw + _i * 8192), 16, 0, 0); } while (0)
#define PG8_LDA(dst, b, h) do { _Pragma("unroll") for (int m = 0; m < 4; ++m) _Pragma("unroll") for (int k = 0; k < 2; ++k) dst[m][k] = *(const LAS h16x8*)(lds + PG8_SA(b, h) + aoff + m * 2048 + k * 1024); } while (0)
#define PG8_LDB(dst, b, h) do { _Pragma("unroll") for (int n = 0; n < 2; ++n) _Pragma("unroll") for (int k = 0; k < 2; ++k) dst[n][k] = *(const LAS h16x8*)(lds + PG8_SB(b, h) + boff + n * 2048 + k * 1024); } while (0)
#define PG8_MMA(ai, bj, At, Bt) do { __builtin_amdgcn_s_setprio(1); _Pragma("unroll") for (int m = 0; m < 4; ++m) _Pragma("unroll") for (int n = 0; n < 2; ++n) _Pragma("unroll") for (int k = 0; k < 2; ++k) \
        acc[ai][bj][m][n] = __builtin_amdgcn_mfma_f32_16x16x32_f16(Bt[n][k], At[m][k], acc[ai][bj][m][n], 0, 0, 0); __builtin_amdgcn_s_setprio(0); } while (0)
#define PG8_WAIT_V(n) asm volatile("s_waitcnt vmcnt(" #n ")" ::: "memory")
#define PG8_WAIT_L(n) asm volatile("s_waitcnt lgkmcnt(" #n ")" ::: "memory")
#define PG8_BAR __builtin_amdgcn_s_barrier()
#define PG8_SCHED __builtin_amdgcn_sched_barrier(0)
    Unit cur, nxt; int ui = 0;
    if (!S.next(0, cur)) return;
    Acc acc;
#pragma unroll
    for (int a = 0; a < 2; ++a)
#pragma unroll
        for (int b = 0; b < 2; ++b)
#pragma unroll
            for (int m = 0; m < 4; ++m)
#pragma unroll
                for (int n = 0; n < 2; ++n) acc[a][b][m][n] = (f32x4){0.f, 0.f, 0.f, 0.f};
    h16x8 At[4][2], B0[2][2], B1[2][2];
    const char* cA = (const char*)g.A + (size_t)cur.pm * tstepA; const char* cB = (const char*)g.Bt + (size_t)cur.pn * tstepB;
    PG8_STAGE(PG8_SB(0, 0), cB, voffB); PG8_STAGE(PG8_SB(0, 1), cB + hstepB, voffB); PG8_STAGE(PG8_SA(0, 0), cA, voffA); PG8_STAGE(PG8_SA(0, 1), cA + hstepA, voffA);
    if (wr == 1) PG8_BAR;
    PG8_WAIT_V(2); PG8_BAR;
    PG8_STAGE(PG8_SB(1, 0), cB + kstep, voffB); PG8_STAGE(PG8_SA(1, 0), cA + kstep, voffA); PG8_STAGE(PG8_SB(1, 1), cB + hstepB + kstep, voffB);
    PG8_WAIT_V(6); PG8_BAR;
    for (;;) {
        const bool has_next = S.next(ui + 1, nxt);
        const char* nA = has_next ? (const char*)g.A + (size_t)nxt.pm * tstepA : cA; const char* nB = has_next ? (const char*)g.Bt + (size_t)nxt.pn * tstepB : cB;
        for (int t = 0; t < nt; t += 2) {
            const bool last = (t == nt - 2);
            const char* a1 = cA + (size_t)(t + 1) * kstep;
            const char* a2 = last ? nA : cA + (size_t)(t + 2) * kstep; const char* b2 = last ? nB : cB + (size_t)(t + 2) * kstep;
            const char* a3 = a2 + kstep; const char* b3 = b2 + kstep;
            PG8_LDB(B0, 0, 0); PG8_LDB(B1, 0, 1); PG8_SCHED; PG8_LDA(At, 0, 0); PG8_STAGE(PG8_SA(1, 1), a1 + hstepA, voffA);
            PG8_WAIT_V(8); PG8_WAIT_L(0); PG8_BAR; PG8_MMA(0, 0, At, B0); PG8_MMA(0, 1, At, B1); PG8_BAR; PG8_SCHED;
            PG8_LDA(At, 0, 1); PG8_STAGE(PG8_SB(0, 0), b2, voffB); PG8_STAGE(PG8_SB(0, 1), b2 + hstepB, voffB); PG8_STAGE(PG8_SA(0, 0), a2, voffA);
            PG8_WAIT_V(8); PG8_WAIT_L(0); PG8_BAR; PG8_MMA(1, 0, At, B0); PG8_MMA(1, 1, At, B1); PG8_BAR; PG8_SCHED;
            PG8_LDB(B0, 1, 0); PG8_LDB(B1, 1, 1); PG8_SCHED; PG8_LDA(At, 1, 0); PG8_STAGE(PG8_SA(0, 1), a2 + hstepA, voffA);
            PG8_WAIT_V(8); PG8_WAIT_L(0); PG8_BAR; PG8_MMA(0, 0, At, B0); PG8_MMA(0, 1, At, B1); PG8_BAR; PG8_SCHED;
            PG8_LDA(At, 1, 1); PG8_STAGE(PG8_SB(1, 0), b3, voffB); PG8_STAGE(PG8_SB(1, 1), b3 + hstepB, voffB); PG8_STAGE(PG8_SA(1, 0), a3, voffA);
            PG8_WAIT_V(8); PG8_WAIT_L(0); PG8_BAR; PG8_MMA(1, 0, At, B0); PG8_MMA(1, 1, At, B1); PG8_BAR; PG8_SCHED;
        }
        if (wr == 0) PG8_BAR;
        { int t2 = threadIdx.x; asm volatile("" : "+v"(t2)); const int w2 = __builtin_amdgcn_readfirstlane(t2 >> 6), l2 = t2 & 63; E(acc, cur, w2 >> 2, w2 & 3, l2 & 15, l2 >> 4); }
        if (!has_next) break;
#pragma unroll
        for (int a = 0; a < 2; ++a)
#pragma unroll
            for (int b = 0; b < 2; ++b)
#pragma unroll
                for (int m = 0; m < 4; ++m)
#pragma unroll
                    for (int n = 0; n < 2; ++n) acc[a][b][m][n] = (f32x4){0.f, 0.f, 0.f, 0.f};
        cur = nxt; cA = nA; cB = nB; ++ui;
        if (wr == 1) PG8_BAR;
    }
    PG8_WAIT_V(0);
    PG8_BAR;
#undef PG8_SA
#undef PG8_SB
#undef PG8_STAGE
#undef PG8_LDA
#undef PG8_LDB
#undef PG8_MMA
#undef PG8_WAIT_V
#undef PG8_WAIT_L
#undef PG8_BAR
#undef PG8_SCHED
}

#define EPI_ROWS(...) _Pragma("unroll") for (int ai = 0; ai < 2; ++ai) _Pragma("unroll") for (int m = 0; m < 4; ++m) { const int r = u.pm * BM + ai * HALF + wr * 64 + m * 16 + fr; __VA_ARGS__ asm volatile("" ::: "memory"); }
#define EPI_COLS(...) _Pragma("unroll") for (int bj = 0; bj < 2; ++bj) { const int c = u.pn * BM + bj * HALF + wc * 32 + 8 * fq; const f32x4 v0 = acc[ai][bj][m][0], v1 = acc[ai][bj][m][1]; __VA_ARGS__ }
__device__ __forceinline__ float rstd_from(const float* part, int r) {
    const f32x4* pp = (const f32x4*)(part + (size_t)r * 16); const f32x4 a = pp[0], b = pp[1], c = pp[2], d = pp[3];
    const float ss = ((a[0] + a[1]) + (a[2] + a[3])) + ((b[0] + b[1]) + (b[2] + b[3])) + ((c[0] + c[1]) + (c[2] + c[3])) + ((d[0] + d[1]) + (d[2] + d[3]));
    return __builtin_amdgcn_rsqf(ss * (1.0f / 1024.0f) + EPS);
}
__device__ __forceinline__ h16x8 pack8(f32x4 a, f32x4 b) { h16x8 o; o[0] = (h16)a[0]; o[1] = (h16)a[1]; o[2] = (h16)a[2]; o[3] = (h16)a[3]; o[4] = (h16)b[0]; o[5] = (h16)b[1]; o[6] = (h16)b[2]; o[7] = (h16)b[3]; return o; }
struct EpiZ { h16* z; const float* part; bool dry;
    __device__ __forceinline__ void operator()(const Acc& acc, const Unit& u, int wr, int wc, int fr, int fq) const {
        EPI_ROWS( const float rs = rstd_from(part, r); EPI_COLS( if (!dry) *(h16x8*)(z + (size_t)r * ZW + c) = pack8(v0 * rs, v1 * rs); ) )
    } };
struct EpiD1 { h16* z; bool dry;
    __device__ __forceinline__ void operator()(const Acc& acc, const Unit& u, int wr, int wc, int fr, int fq) const {
        EPI_ROWS( EPI_COLS( h16x8* p = (h16x8*)(z + (size_t)r * ZW + C_MGA + c); const h16x8 gte = *p; h16x8 o;
            _Pragma("unroll") for (int i = 0; i < 4; ++i) { o[i] = (h16)(v0[i] * sigm((float)gte[i])); o[4 + i] = (h16)(v1[i] * sigm((float)gte[4 + i])); } if (!dry) *p = o; ) )
    } };
struct EpiD2 { h16* z; bool dry;
    __device__ __forceinline__ void operator()(const Acc& acc, const Unit& u, int wr, int wc, int fr, int fq) const {
        EPI_ROWS( EPI_COLS( h16x8* p = (h16x8*)(z + (size_t)r * ZW + C_MGA + c); const h16x8 t1 = *p; const h16x8 gte = *(const h16x8*)(z + (size_t)r * ZW + C_MGF + c); h16x8 o;
            _Pragma("unroll") for (int i = 0; i < 4; ++i) { o[i] = (h16)((float)t1[i] + v0[i] * sigm((float)gte[i])); o[4 + i] = (h16)((float)t1[4 + i] + v1[i] * sigm((float)gte[4 + i])); } if (!dry) *p = o; ) )
    } };
struct EpiE { const h16* ha; h16* z; float* part; bool dry;
    __device__ __forceinline__ void operator()(const Acc& acc, const Unit& u, int wr, int wc, int fr, int fq) const {
        EPI_ROWS( float ss = 0.f;
            EPI_COLS( const h16x8 hv = *(const h16x8*)(ha + (size_t)r * DM + c); f32x4 a, b;
                _Pragma("unroll") for (int i = 0; i < 4; ++i) { a[i] = (float)hv[i] + v0[i]; b[i] = (float)hv[4 + i] + v1[i]; }
                if (!dry) *(h16x8*)(z + (size_t)r * ZW + C_MGF + c) = pack8(a, b);
                ss += (a[0] * a[0] + a[1] * a[1]) + (a[2] * a[2] + a[3] * a[3]) + (b[0] * b[0] + b[1] * b[1]) + (b[2] * b[2] + b[3] * b[3]); )
            ss += __shfl_xor(ss, 16); ss += __shfl_xor(ss, 32); if (fq == 0 && !dry) part[(size_t)r * 16 + u.pn * 4 + wc] = ss; )
    } };
struct EpiF1 { h16* z; const float* part; bool dry;
    __device__ __forceinline__ void operator()(const Acc& acc, const Unit& u, int wr, int wc, int fr, int fq) const {
        EPI_ROWS( const float rs = rstd_from(part, r); EPI_COLS( h16x8 o;
            _Pragma("unroll") for (int i = 0; i < 4; ++i) { o[i] = (h16)sigm(v0[i] * rs); o[4 + i] = (h16)sigm(v1[i] * rs); } if (!dry) *(h16x8*)(z + (size_t)r * ZW + C_MGA + c) = o; ) )
    } };
struct EpiF2 { const h16* z; h16* ha; float* part; bool dry;
    __device__ __forceinline__ void operator()(const Acc& acc, const Unit& u, int wr, int wc, int fr, int fq) const {
        EPI_ROWS( float ss = 0.f;
            EPI_COLS( const h16x8 gt = *(const h16x8*)(z + (size_t)r * ZW + C_MGA + c); const h16x8 hv = *(const h16x8*)(z + (size_t)r * ZW + C_MGF + c); f32x4 a, b;
                _Pragma("unroll") for (int i = 0; i < 4; ++i) { a[i] = (float)hv[i] + v0[i] * (float)gt[i]; b[i] = (float)hv[4 + i] + v1[i] * (float)gt[4 + i]; }
                if (!dry) *(h16x8*)(ha + (size_t)r * DM + c) = pack8(a, b);
                ss += (a[0] * a[0] + a[1] * a[1]) + (a[2] * a[2] + a[3] * a[3]) + (b[0] * b[0] + b[1] * b[1]) + (b[2] * b[2] + b[3] * b[3]); )
            ss += __shfl_xor(ss, 16); ss += __shfl_xor(ss, 32); if (fq == 0 && !dry) part[(size_t)r * 16 + u.pn * 4 + wc] = ss; )
    } };
}

struct Args { const float* in[15]; float* out; unsigned char* ws; int step_lo, step_hi, probe, pad; };
struct Grp { int B, S, M, N1; const float* x; const float* p; float* out; size_t p_lstride; };

__device__ __forceinline__ h16x8 ld8(const h16* p) { return *(const h16x8*)p; }
__device__ __forceinline__ h16x4 ld4(const h16* p) { return *(const h16x4*)p; }
__device__ __forceinline__ h16x4 tr4(const LAS unsigned char* p) { return __builtin_bit_cast(h16x4, __builtin_amdgcn_ds_read_tr16_b64_v4i16((LAS v4i16_t*)p)); }
__device__ __forceinline__ h16x8 cat8(h16x4 a, h16x4 b) { return (h16x8){a[0], a[1], a[2], a[3], b[0], b[1], b[2], b[3]}; }
__device__ __forceinline__ h16x8 pack_lo(const f32x16& v) { h16x8 o; _Pragma("unroll") for (int i = 0; i < 8; ++i) o[i] = (h16)v[i]; return o; }
__device__ __forceinline__ h16x8 pack_hi(const f32x16& v) { h16x8 o; _Pragma("unroll") for (int i = 0; i < 8; ++i) o[i] = (h16)v[8 + i]; return o; }
#define MFMA32(a, b, c) __builtin_amdgcn_mfma_f32_32x32x16_f16(a, b, c, 0, 0, 0)
__device__ __forceinline__ void widen16(f32x16& v) { _Pragma("unroll") for (int jp = 0; jp < 2; ++jp) _Pragma("unroll") for (int e = 0; e < 4; ++e) {
    auto r = __builtin_amdgcn_permlane32_swap(__float_as_uint(v[8 * jp + e]), __float_as_uint(v[8 * jp + 4 + e]), false, false); v[8 * jp + e] = __uint_as_float(r[0]); v[8 * jp + 4 + e] = __uint_as_float(r[1]); } }
__device__ __forceinline__ h16x8 neg8(h16x8 v) { typedef unsigned u32x4 __attribute__((ext_vector_type(4))); u32x4 u = __builtin_bit_cast(u32x4, v); u = u ^ 0x80008000u; return __builtin_bit_cast(h16x8, u); }
__device__ __forceinline__ h16x4 lds4(const LAS unsigned char* p) { return *(const LAS h16x4*)p; }


#define XB_TMO      128
#define XB_XCNT(j)  (256  + 64 * (j))
#define XB_XSUB(j)  (1280 + 64 * (j))
#define XB_XGEN(j)  (2304 + 64 * (j))
#define XB_TOP      3328
#define XB_TOPGEN   3392
#define XB_SPIN_CAP (1u << 22)
__device__ __forceinline__ unsigned xb_ld(unsigned* p)              { return __hip_atomic_load(p, __ATOMIC_RELAXED, __HIP_MEMORY_SCOPE_AGENT); }
__device__ __forceinline__ unsigned xb_add(unsigned* p, unsigned v) { return __hip_atomic_fetch_add(p, v, __ATOMIC_RELAXED, __HIP_MEMORY_SCOPE_AGENT); }
__device__ __forceinline__ unsigned xb_xcc_id() { return (unsigned)__builtin_amdgcn_s_getreg((3 << 11) | 20) & 0xFu; }
#define XB_SPIN(cond, bar) do { unsigned _sp = 0; while (cond) { __builtin_amdgcn_s_sleep(1); \
    if ((++_sp & 255u) == 0u) { if (xb_ld(&(bar)[XB_TMO])) break; if (_sp > XB_SPIN_CAP) { atomicAdd(&(bar)[XB_TMO], 1u); break; } } } } while (0)
struct XcdBarrier { unsigned* bar; unsigned x; volatile LAS unsigned* st; };
__device__ __forceinline__ XcdBarrier xcd_barrier_post(unsigned* bar, volatile LAS unsigned* st) {
    XcdBarrier b; b.bar = bar; b.x = xb_xcc_id(); b.st = st;
    if (threadIdx.x == 0) (void)xb_add(&bar[XB_XCNT(b.x)], 1u);
    return b;
}
__device__ __forceinline__ void xcd_barrier_complete(unsigned* bar, unsigned x, unsigned& nloc, unsigned& nx) {
    const unsigned G = GRID;
    unsigned sum, cnt, mine, sp = 0u;
    for (;;) {
        sum = 0u; cnt = 0u; mine = 0u;
#pragma unroll
        for (unsigned j = 0; j < 16; ++j) { const unsigned c = xb_ld(&bar[XB_XCNT(j)]); sum += c; cnt += (c > 0u) ? 1u : 0u; mine = (j == x) ? c : mine; }
        if (sum == G) break;
        __builtin_amdgcn_s_sleep(1);
        if ((++sp & 255u) == 0u) { if (xb_ld(&bar[XB_TMO])) break; if (sp > XB_SPIN_CAP) { atomicAdd(&bar[XB_TMO], 1u); break; } }
    }
    nloc = mine > 0u ? mine : 1u; nx = cnt > 0u ? cnt : 1u;
}
__device__ __forceinline__ void xcd_barrier(const XcdBarrier& b) {
    asm volatile("s_waitcnt vmcnt(0)" ::: "memory");
    __syncthreads();
    if (threadIdx.x == 0) {
        unsigned* bar = b.bar;
        __builtin_amdgcn_s_waitcnt(0);
        unsigned nloc = b.st[0], nx = b.st[1];
        if (nloc == 0u) { xcd_barrier_complete(bar, b.x, nloc, nx); b.st[0] = nloc; b.st[1] = nx; }
        const unsigned old = xb_add(&bar[XB_XSUB(b.x)], 1u);
        const unsigned gen = old / nloc;
        if (old + 1u == (gen + 1u) * nloc) {
            __builtin_amdgcn_fence(__ATOMIC_RELEASE, "agent");
            asm volatile("s_waitcnt vmcnt(0)" ::: "memory");
            const unsigned og = xb_add(&bar[XB_TOP], 1u);
            const unsigned tg = og / nx;
            if (og + 1u == (tg + 1u) * nx) xb_add(&bar[XB_TOPGEN], 1u);
            else XB_SPIN(xb_ld(&bar[XB_TOPGEN]) == tg, bar);
            __builtin_amdgcn_fence(__ATOMIC_ACQUIRE, "agent");
            xb_add(&bar[XB_XGEN(b.x)], 1u);
            asm volatile("s_waitcnt vmcnt(0)" ::: "memory");
        } else {
            XB_SPIN(xb_ld(&bar[XB_XGEN(b.x)]) == gen, bar);
            __builtin_amdgcn_fence(__ATOMIC_ACQUIRE, "agent");
            asm volatile("s_waitcnt vmcnt(0)" ::: "memory");
        }
    }
    __syncthreads();
}

__device__ __forceinline__ void transpose_item(const float* W, int K, int N, h16* WT, const float* kscale, LAS float* scr, int item, int lane) {
    const int nblk = N / 32, kb = item / nblk, nb = item % nblk, k0 = 64 * kb, n0 = 32 * nb;
#pragma unroll 8
    for (int i = 0; i < 32; ++i) { const int kk = 2 * i + (lane >> 5); float v = W[(size_t)(k0 + kk) * N + n0 + (lane & 31)]; if (kscale) v *= kscale[k0 + kk]; scr[kk * 33 + (lane & 31)] = v; }
    asm volatile("s_waitcnt lgkmcnt(0)" ::: "memory");
    const int c = lane & 7;
#pragma unroll
    for (int j = 0; j < 4; ++j) { const int n = (lane >> 3) + 8 * j; const LAS float* s = scr + (8 * c) * 33 + n;
        h16x8 o; _Pragma("unroll") for (int e = 0; e < 8; ++e) o[e] = (h16)s[e * 33];
        *(h16x8*)(WT + (size_t)(n0 + n) * K + k0 + 8 * c) = o; }
    asm volatile("s_waitcnt lgkmcnt(0)" ::: "memory");
}

__device__ __forceinline__ void prologue(const Args& a, LAS unsigned char* lds) {
    int tid_ = threadIdx.x; asm volatile("" : "+v"(tid_));
    const int tid = tid_, lane = tid & 63, wave = tid >> 6;
    const int gw = blockIdx.x * 8 + wave, NGW = GRID * 8;
    LAS float* scr = (LAS float*)(lds + wave * 16384);
    h16* Wb = (h16*)(a.ws + WS_W);
    constexpr int I_IN = (DM / 64) * (ZW / 32), I_AO = (512 / 64) * (DM / 32), I_OUT = (DM / 64) * (DM / 32), I_PE = (PLE / 64) * (DM / 32), I_FM = 4 * (128 / 64) * (128 / 32);
    constexpr int I_L = I_IN + 2 * I_AO + 2 * I_OUT + I_PE + I_FM;
#pragma unroll 1
    for (int it = gw; it < DEPTH * I_L; it += NGW) {
        const int l = it / I_L; int r = it % I_L; h16* wl = Wb + (size_t)l * LW_SZ;
        if (r < I_IN) { transpose_item(a.in[5] + (size_t)l * DM * ZW, DM, ZW, wl + LW_IN, a.in[4] + l * DM, scr, r, lane); continue; } r -= I_IN;
        if (r < I_AO) { transpose_item(a.in[8] + (size_t)l * 512 * DM, 512, DM, wl + LW_AO, nullptr, scr, r, lane); continue; } r -= I_AO;
        if (r < I_AO) { transpose_item(a.in[9] + (size_t)l * 512 * DM, 512, DM, wl + LW_FO, nullptr, scr, r, lane); continue; } r -= I_AO;
        if (r < I_OUT) { transpose_item(a.in[10] + (size_t)l * DM * DM, DM, DM, wl + LW_OUT, nullptr, scr, r, lane); continue; } r -= I_OUT;
        if (r < I_OUT) { transpose_item(a.in[13] + (size_t)l * DM * DM, DM, DM, wl + LW_PG, a.in[12] + l * DM, scr, r, lane); continue; } r -= I_OUT;
        if (r < I_PE) { transpose_item(a.in[11] + (size_t)l * PLE * DM, PLE, DM, wl + LW_PE, nullptr, scr, r, lane); continue; } r -= I_PE;
        { const int g = r / 8, rr = r % 8; transpose_item(a.in[7] + ((size_t)l * 4 + g) * 128 * 128, 128, 128, wl + LW_FM + (size_t)g * 128 * 128, nullptr, scr, rr, lane); }
    }
    const int gt = blockIdx.x * 512 + tid, NGT = GRID * 512;
    const float invf[8] = {1.0f, 0.19392274f, 0.03760603f, 0.0072926646f, 0.0014142136f, 0.0002742482f, 5.3182957e-05f, 1.0313385e-05f};
    f32x2* rope = (f32x2*)(a.ws + WS_ROPE);
#pragma unroll 1
    for (int i = gt; i < 8192 * 8; i += NGT) { const int pos = i >> 3, j = i & 7;
        float fq = 1.0f; _Pragma("unroll") for (int q = 0; q < 8; ++q) if (j == q) fq = invf[q];
        const float ang = (float)pos * fq; double rev = (double)ang * 0.15915494309189535; rev -= rint(rev);
        float s, c; sincospif((float)(2.0 * rev), &s, &c); rope[i] = (f32x2){c, s}; }
    h16* t1a = (h16*)(a.ws + WS_T1A);
#pragma unroll 1
    for (int i = gt; i < 256 * 128; i += NGT) { const int n = i >> 7, c = i & 127, d = n & 127; float s, co; sincospif((float)((d * c) & 127) * (2.0f / 128.0f), &s, &co);
        t1a[i] = (h16)((n < 128 ? co : -s) * 0.08838834764831845f); }
    {   h16* t = (h16*)(a.ws + WS_T1B64);
#pragma unroll 1
        for (int i = gt; i < 64 * 128; i += NGT) { const int k1 = i >> 7, col = i & 127, s1 = col & 63; float s, co; sincospif((float)((k1 * s1) & 63) * (2.0f / 64.0f), &s, &co);
            t[i] = (h16)((col < 64 ? co : s) * 0.125f); } }
    {   h16* t = (h16*)(a.ws + WS_T1B128);
#pragma unroll 1
        for (int i = gt; i < 128 * 256; i += NGT) { const int k1 = i >> 8, col = i & 255, s1 = col & 127; float s, co; sincospif((float)((k1 * s1) & 127) * (2.0f / 128.0f), &s, &co);
            t[i] = (h16)((col < 128 ? co : s) * 0.08838834764831845f); } }
    {   h16* t = (h16*)(a.ws + WS_T2);
#pragma unroll 1
        for (int i = gt; i < 64 * 128; i += NGT) { const int k2 = i >> 7, col = i & 127, s2 = col & 63; float s, co; sincospif((float)((k2 * s2) & 63) * (2.0f / 64.0f), &s, &co);
            t[i] = (h16)((col < 64 ? co : s) * 0.125f); } }
    {   f32x2* t = (f32x2*)(a.ws + WS_TW64);
#pragma unroll 1
        for (int i = gt; i < 64 * 64; i += NGT) { const int k1 = i >> 6, s2 = i & 63; float s, co; sincospif((float)(k1 * s2) * (2.0f / 4096.0f), &s, &co); t[i] = (f32x2){co, s}; } }
    {   f32x2* t = (f32x2*)(a.ws + WS_TW128);
#pragma unroll 1
        for (int i = gt; i < 128 * 64; i += NGT) { const int k1 = i >> 6, s2 = i & 63; float s, co; sincospif((float)(k1 * s2) * (2.0f / 8192.0f), &s, &co); t[i] = (f32x2){co, s}; } }
}

__device__ __forceinline__ void group_start(const Grp& G, h16* ha, float* part2) {
    int tid_ = threadIdx.x; asm volatile("" : "+v"(tid_));
    const int lane = tid_ & 63, gw = blockIdx.x * 8 + (tid_ >> 6), NGW = GRID * 8;
#pragma unroll 1
    for (int r = gw; r < G.M; r += NGW) {
        const f32x4* xr = (const f32x4*)(G.x + (size_t)r * DM) + lane; float ss = 0.f;
#pragma unroll
        for (int j = 0; j < 4; ++j) { const f32x4 v = xr[64 * j]; ss += (v[0] * v[0] + v[1] * v[1]) + (v[2] * v[2] + v[3] * v[3]);
            h16x4 o = {(h16)v[0], (h16)v[1], (h16)v[2], (h16)v[3]}; *((h16x4*)(ha + (size_t)r * DM) + lane + 64 * j) = o; }
#pragma unroll
        for (int o = 1; o < 64; o <<= 1) ss += __shfl_xor(ss, o);
        if (lane < 16) part2[(size_t)r * 16 + lane] = (lane == 0) ? ss : 0.f;
    }
}
__device__ __forceinline__ void convert_p(const Grp& G, int layer, h16* p16) {
    const f32x4* src = (const f32x4*)(G.p + (size_t)layer * G.p_lstride); const size_t n4 = (size_t)G.M * PLE / 4;
    int tid_ = threadIdx.x; asm volatile("" : "+v"(tid_));
#pragma unroll 1
    for (size_t i = (size_t)blockIdx.x * 512 + tid_; i < n4; i += (size_t)GRID * 512) { const f32x4 v = src[i]; h16x4 o = {(h16)v[0], (h16)v[1], (h16)v[2], (h16)v[3]}; ((h16x4*)p16)[i] = o; }
}
__device__ __forceinline__ void final_norm(const Grp& G, const h16* ha, const float* part2, const float* lnf) {
    int tid_ = threadIdx.x; asm volatile("" : "+v"(tid_));
    const int lane = tid_ & 63, gw = blockIdx.x * 8 + (tid_ >> 6), NGW = GRID * 8;
#pragma unroll 1
    for (int r = gw; r < G.M; r += NGW) {
        const float rs = pg8::rstd_from(part2, r);
        f32x4* xr = (f32x4*)(G.out + (size_t)r * DM) + lane; const h16x4* hr = (const h16x4*)(ha + (size_t)r * DM) + lane;
#pragma unroll
        for (int j = 0; j < 4; ++j) { const f32x4 w = ((const f32x4*)lnf)[lane + 64 * j]; const h16x4 hv = hr[64 * j]; xr[64 * j] = (f32x4){(float)hv[0], (float)hv[1], (float)hv[2], (float)hv[3]} * rs * w; }
    }
}

constexpr int KS_STRIDE = 144, VS_STRIDE = 192, KS_BYTES = 384 * KS_STRIDE;
__device__ __forceinline__ void attn_unit(LAS unsigned char* lds, h16* z, h16* obase, int ostride, const f32x2* rope, const float* sink, int S, int b, int nb, int g) {
    int tid_ = threadIdx.x; asm volatile("" : "+v"(tid_));
    const int tid = tid_, lane = tid & 63, wid = tid >> 6, l31 = lane & 31, hi = lane >> 5;
    LAS unsigned char* Ks = lds; LAS unsigned char* Vs = lds + KS_BYTES;
    const int kb0 = nb * 128 - 128;
    const size_t rowbase = (size_t)b * S;
#pragma unroll
    for (int i = 0; i < 3; ++i) { const int item = tid + 512 * i, kk = item >> 2, c4 = item & 3, pos = kb0 + kk;
        h16x8 v0 = {}, v1 = {};
        if (pos >= 0 && pos < S) { const h16* src = z + (rowbase + pos) * ZW + C_K + g * 64 + c4 * 16; v0 = ld8(src); v1 = ld8(src + 8);
            if (c4 == 0) { const f32x2* rp = rope + (size_t)pos * 8; h16x8 o0, o1;
                _Pragma("unroll") for (int j = 0; j < 8; ++j) { const f32x2 cs = rp[j]; const float x1 = (float)v0[j], x2 = (float)v1[j]; o0[j] = (h16)(x1 * cs[0] - x2 * cs[1]); o1[j] = (h16)(x2 * cs[0] + x1 * cs[1]); }
                v0 = o0; v1 = o1; } }
        *(LAS h16x8*)(Ks + kk * KS_STRIDE + c4 * 32) = v0; *(LAS h16x8*)(Ks + kk * KS_STRIDE + c4 * 32 + 16) = v1; }
#pragma unroll
    for (int i = 0; i < 6; ++i) { const int item = tid + 512 * i, kk = item >> 3, c8 = item & 7, pos = kb0 + kk;
        h16x8 v = {}; if (pos >= 0 && pos < S) v = ld8(z + (rowbase + pos) * ZW + C_V + g * 64 + c8 * 8);
        *(LAS h16x8*)(Vs + kk * VS_STRIDE + c8 * 16) = v; }
    __syncthreads();
    const float CS = 0.125f * 1.44269504089f;
    const bool edge_block = (nb == 0) || (nb == S / 128 - 1);
    const int blk = (lane >> 4) & 1, q4 = (lane & 15) >> 2, p4 = lane & 3;
#pragma unroll 1
    for (int it = 0; it < 2; ++it) {
        const int item = wid + 8 * it, hh = item >> 2, rg = item & 3, head = g * 4 + hh;
        const int qi = nb * 128 + rg * 32 + l31;
        h16* qrow = z + (rowbase + qi) * ZW + C_Q + head * 64;
        h16x8 qf[4];
        {   const h16x8 a0 = ld8(qrow), a1 = ld8(qrow + 8); const f32x2* rp = rope + (size_t)qi * 8; h16x8 o;
            _Pragma("unroll") for (int j = 0; j < 8; ++j) { const f32x2 cs = rp[j]; const float x1 = (float)a0[j], x2 = (float)a1[j]; o[j] = hi ? (h16)(x2 * cs[0] + x1 * cs[1]) : (h16)(x1 * cs[0] - x2 * cs[1]); }
            qf[0] = o; }
#pragma unroll
        for (int ks = 1; ks < 4; ++ks) qf[ks] = ld8(qrow + 16 * ks + 8 * hi);
        const float sk = sink[head] * 1.44269504089f;
        float mrun = sk, lrun = hi ? 0.f : 1.f;
        f32x16 o0 = {}, o1 = {};
#pragma unroll 1
        for (int tt = 0; tt < 9; ++tt) {
            const int t = rg + tt;
            f32x16 st = {};
            const LAS unsigned char* kp = Ks + (32 * t + l31) * KS_STRIDE + hi * 16;
#pragma unroll
            for (int ks = 0; ks < 4; ++ks) st = MFMA32(*(const LAS h16x8*)(kp + ks * 32), qf[ks], st);
            const bool need_mask = edge_block || tt == 0 || tt == 8;
            float mx = -3.0e38f;
#pragma unroll
            for (int j = 0; j < 16; ++j) { float s = st[j] * CS;
                if (need_mask) { const int pos = kb0 + 32 * t + (j & 3) + 8 * (j >> 2) + 4 * hi; const int rel = pos - qi; const bool ok = (pos >= 0) && (pos < S) && (rel <= 128) && (rel >= -128); s = ok ? s : -1.0e30f; }
                st[j] = s; mx = fmaxf(mx, s); }
            mx = fmaxf(mx, __shfl_xor(mx, 32));
            const float mnew = fmaxf(mrun, mx), alpha = __builtin_amdgcn_exp2f(mrun - mnew);
            mrun = mnew; float ps = 0.f;
#pragma unroll
            for (int j = 0; j < 16; ++j) { const float p = __builtin_amdgcn_exp2f(st[j] - mnew); st[j] = p; ps += p; }
            lrun = lrun * alpha + ps;
#pragma unroll
            for (int j = 0; j < 16; ++j) { o0[j] *= alpha; o1[j] *= alpha; }
            const h16x8 pk0 = pack_lo(st), pk1 = pack_hi(st);
            const LAS unsigned char* vp = Vs + (32 * t + 4 * hi + q4) * VS_STRIDE + (16 * blk + 4 * p4) * 2;
#pragma unroll
            for (int u = 0; u < 2; ++u) {
                const h16x8 va0 = cat8(tr4(vp + (16 * u) * VS_STRIDE), tr4(vp + (16 * u + 8) * VS_STRIDE));
                const h16x8 va1 = cat8(tr4(vp + (16 * u) * VS_STRIDE + 64), tr4(vp + (16 * u + 8) * VS_STRIDE + 64));
                o0 = MFMA32(va0, u ? pk1 : pk0, o0); o1 = MFMA32(va1, u ? pk1 : pk0, o1);
            }
        }
        const float ltot = lrun + __shfl_xor(lrun, 32), inv = 1.0f / ltot;
        const h16* garow = z + (rowbase + qi) * ZW + C_GA + head * 64 + 8 * hi;
        h16* orow = obase + (rowbase + qi) * ostride + head * 64 + 8 * hi;
        widen16(o0); widen16(o1);
#pragma unroll
        for (int mb = 0; mb < 2; ++mb)
#pragma unroll
            for (int jp = 0; jp < 2; ++jp) { const int d = 32 * mb + 16 * jp; const h16x8 gv = ld8(garow + d); h16x8 o;
                _Pragma("unroll") for (int e = 0; e < 8; ++e) { const float ga = (float)gv[e]; const float ov = (mb ? o1[8 * jp + e] : o0[8 * jp + e]) * inv; o[e] = (h16)(ov * ga * sigm(ga)); }
                *(h16x8*)(orow + d) = o; }
    }
    __syncthreads();
}

template <int N1> struct F1Geo { static constexpr int US = 528, TS = 4 * N1 + 8, TOFF = N1 * US; };
template <int N1>
__device__ __forceinline__ void f1_load_table(LAS unsigned char* lds, const h16* tcs) {
    int tid_ = threadIdx.x; asm volatile("" : "+v"(tid_));
    constexpr int CPR = N1 / 4;
#pragma unroll
    for (int i = 0; i < N1 * CPR / 512; ++i) { const int item = tid_ + 512 * i, row = item / CPR, ch = item % CPR; const h16x8 v = ld8(tcs + (size_t)row * 2 * N1 + ch * 8);
        LAS unsigned char* d = lds + F1Geo<N1>::TOFF + row * F1Geo<N1>::TS + ch * 16;
        *(LAS h16x4*)d = (h16x4){v[0], v[1], v[2], v[3]}; *(LAS h16x4*)(d + 8) = (h16x4){v[4], v[5], v[6], v[7]}; }
    __syncthreads();
}
template <int N1>
__device__ __forceinline__ void f1_unit(LAS unsigned char* lds, const h16* z, h16* Gb, const h16* t1a, const f32x2* tw, int S, int b, int s2, int gp) {
    constexpr int US = F1Geo<N1>::US, TS = F1Geo<N1>::TS, NRB = N1 / 32;
    int tid_ = threadIdx.x; asm volatile("" : "+v"(tid_));
    const int tid = tid_, lane = tid & 63, wid = tid >> 6, l31 = lane & 31, hi = lane >> 5;
    const size_t rowbase = (size_t)b * S;
#pragma unroll
    for (int i = 0; i < N1 / 16; ++i) { const int item = tid + 512 * i, s1 = item >> 5, ch = item & 31;
        *(LAS h16x8*)(lds + s1 * US + ch * 16) = ld8(z + (rowbase + 64 * s1 + s2) * ZW + C_UF + gp * 256 + ch * 8); }
    __syncthreads();
    const int gl = wid >> 2, dq = wid & 3, g = gp * 2 + gl;
    h16x8 Xs[2][NRB][2];
#pragma unroll
    for (int part = 0; part < 2; ++part) {
        h16x8 bf[8];
#pragma unroll
        for (int ks = 0; ks < 8; ++ks) bf[ks] = ld8(t1a + (size_t)(part * 128 + dq * 32 + l31) * 128 + 16 * ks + 8 * hi);
#pragma unroll
        for (int rb = 0; rb < NRB; ++rb) { f32x16 acc = {};
            const LAS unsigned char* up = lds + (rb * 32 + l31) * US + (gl * 128 + 8 * hi) * 2;
#pragma unroll
            for (int ks = 0; ks < 8; ++ks) acc = MFMA32(*(const LAS h16x8*)(up + ks * 32), bf[ks], acc);
            Xs[part][rb][0] = pack_lo(acc); Xs[part][rb][1] = pack_hi(acc); }
    }
    h16x8 XsN[NRB][2];
#pragma unroll
    for (int rb = 0; rb < NRB; ++rb) { XsN[rb][0] = neg8(Xs[0][rb][0]); XsN[rb][1] = neg8(Xs[0][rb][1]); }
#pragma unroll 1
    for (int kb = 0; kb < NRB; ++kb) {
        f32x16 aR = {}, aI = {};
        const LAS unsigned char* trow = lds + F1Geo<N1>::TOFF + (kb * 32 + l31) * TS + 8 * hi;
#pragma unroll
        for (int rb = 0; rb < NRB; ++rb)
#pragma unroll
            for (int t = 0; t < 2; ++t) { const int co = (rb * 32 + 16 * t) * 2;
                const h16x8 wc = cat8(lds4(trow + co), lds4(trow + co + 16)), wsn = cat8(lds4(trow + 2 * N1 + co), lds4(trow + 2 * N1 + co + 16));
                aR = MFMA32(Xs[0][rb][t], wc, aR); aR = MFMA32(Xs[1][rb][t], wsn, aR);
                aI = MFMA32(Xs[1][rb][t], wc, aI); aI = MFMA32(XsN[rb][t], wsn, aI); }
        const int k1 = kb * 32 + l31; const f32x2 cs = tw[k1 * 64 + s2];
        f32x16 gr, gi;
#pragma unroll
        for (int j = 0; j < 16; ++j) { gr[j] = aR[j] * cs[0] + aI[j] * cs[1]; gi[j] = aI[j] * cs[0] - aR[j] * cs[1]; }
        widen16(gr); widen16(gi);
        h16* grow = Gb + (rowbase + (size_t)k1 * 64 + s2) * 1024 + g * 256 + dq * 32 + 8 * hi;
#pragma unroll
        for (int jp = 0; jp < 2; ++jp) { h16x8 orr, oi;
            _Pragma("unroll") for (int e = 0; e < 8; ++e) { orr[e] = (h16)gr[8 * jp + e]; oi[e] = (h16)gi[8 * jp + e]; }
            *(h16x8*)(grow + 16 * jp) = orr; *(h16x8*)(grow + 128 + 16 * jp) = oi; }
    }
    __syncthreads();
}

__device__ __forceinline__ void f2_unit(LAS unsigned char* lds, h16* z, const h16* Gb, const h16* wfm, const h16x8 (&bt2)[8], int S, int N1, int b, int k1) {
    constexpr int GS = 2112;
    int tid_ = threadIdx.x; asm volatile("" : "+v"(tid_));
    const int tid = tid_, lane = tid & 63, wid = tid >> 6, l31 = lane & 31, hi = lane >> 5;
    const int blk = (lane >> 4) & 1, q4 = (lane & 15) >> 2, p4 = lane & 3;
    const size_t rowbase = (size_t)b * S;
    const h16* gsrc = Gb + (rowbase + (size_t)k1 * 64) * 1024;
#pragma unroll
    for (int i = 0; i < 16; ++i) { const int item = tid + 512 * i, s2 = item >> 7, ch = item & 127;
        *(LAS h16x8*)(lds + s2 * GS + ch * 16) = ld8(gsrc + (size_t)s2 * 1024 + ch * 8); }
    __syncthreads();
    const int g = wid >> 1, kb2 = wid & 1;
    h16x8 Ys[4][2];
#pragma unroll
    for (int db = 0; db < 4; ++db) { f32x16 acc = {};
#pragma unroll
        for (int kk = 0; kk < 8; ++kk) { const int part = kk >> 2, ks = kk & 3;
            const LAS unsigned char* ap = lds + (16 * ks + 8 * hi + q4) * GS + (g * 256 + part * 128 + 32 * db + 16 * blk + 4 * p4) * 2;
            acc = MFMA32(cat8(tr4(ap), tr4(ap + 4 * GS)), bt2[kk], acc); }
        Ys[db][0] = pack_lo(acc); Ys[db][1] = pack_hi(acc); }
    const int k2 = kb2 * 32 + l31; const size_t trow = rowbase + k1 + (size_t)N1 * k2;
    const h16* gfrow = z + trow * ZW + C_GF + g * 128; h16* frow = z + trow * ZW + C_UF + g * 128;
    const h16* wg = wfm + (size_t)g * 128 * 128;
#pragma unroll 1
    for (int ob = 0; ob < 4; ++ob) { f32x16 acc = {};
        const h16* wr = wg + (size_t)(ob * 32 + l31) * 128 + 4 * hi;
#pragma unroll
        for (int db = 0; db < 4; ++db)
#pragma unroll
            for (int t = 0; t < 2; ++t) { const int co = 32 * db + 16 * t; acc = MFMA32(cat8(ld4(wr + co), ld4(wr + co + 8)), Ys[db][t], acc); }
        widen16(acc);
#pragma unroll
        for (int jp = 0; jp < 2; ++jp) { const int d = 32 * ob + 16 * jp + 8 * hi; const h16x8 gv = ld8(gfrow + d); h16x8 o;
            _Pragma("unroll") for (int e = 0; e < 8; ++e) { const float gf = (float)gv[e]; o[e] = (h16)(acc[8 * jp + e] * gf * sigm(gf)); }
            *(h16x8*)(frow + d) = o; }
    }
    __syncthreads();
}

#ifndef PHM
#define PHM 0xFFFF
#endif
#ifndef PROBE_MASK
#define PROBE_MASK 0
#endif
constexpr int STEPS_PER_GROUP = 2 + DEPTH * 6;
constexpr int N_STEPS = 1 + 2 * STEPS_PER_GROUP;

__global__ void __launch_bounds__(512, 2) fwd_megakernel(Args args) {
    extern __shared__ __attribute__((aligned(16))) unsigned char lds_raw[];
    LAS unsigned char* lds = (LAS unsigned char*)lds_raw;
    cg::grid_group grid = cg::this_grid();
    unsigned char* ws = args.ws;
    h16* z = (h16*)(ws + WS_Z); h16* Gb = (h16*)(ws + WS_G); h16* ha = (h16*)(ws + WS_HA); h16* p16 = (h16*)(ws + WS_P16);
    float* part1 = (float*)(ws + WS_PART1); float* part2 = (float*)(ws + WS_PART2);
    const h16* Wb = (const h16*)(ws + WS_W);
    const f32x2* rope = (const f32x2*)(ws + WS_ROPE);
    const int Gsz = GRID, cid = blockIdx.x;
    volatile LAS unsigned* bst = (volatile LAS unsigned*)(lds + LDS_CTL_OFF);
    if (threadIdx.x < 16) bst[threadIdx.x] = 0u;
    __syncthreads();
    const XcdBarrier xbar = xcd_barrier_post((unsigned*)(ws + WS_BAR), bst);

    if (args.step_lo == 0) { if (PHM & 256) prologue(args, lds); __syncthreads(); grid.sync(); }
#pragma unroll 1
    for (int step = (args.step_lo < 1 ? 1 : args.step_lo); step < args.step_hi; ++step) {
        if (step > 1) { xcd_barrier(xbar); if (args.probe & 128) xcd_barrier(xbar); }
        const int gi = (step - 1) / STEPS_PER_GROUP, ls = (step - 1) % STEPS_PER_GROUP;
        Grp G;
        if (gi == 0) { G.B = 16; G.S = 4096; G.N1 = 64; G.x = args.in[0]; G.p = args.in[2]; G.out = args.out; G.p_lstride = (size_t)16 * 4096 * PLE; }
        else { G.B = 4; G.S = 8192; G.N1 = 128; G.x = args.in[1]; G.p = args.in[3]; G.out = args.out + (size_t)16 * 4096 * DM; G.p_lstride = (size_t)4 * 8192 * PLE; }
        G.M = G.B * G.S;
        if (ls == 0) { if (PHM & 512) group_start(G, ha, part2); continue; }
        if (ls == STEPS_PER_GROUP - 1) { if (PHM & 1024) final_norm(G, ha, part2, args.in[14]); continue; }
        const int layer = (ls - 1) / 6, ph = (ls - 1) % 6;
        const h16* wl = Wb + (size_t)layer * LW_SZ;
        pg8::StaticOrder<ZW / 256> SOA; pg8::StaticOrder<DM / 256> SO;
        const int pb = args.probe;
        if (ph == 0 && (PHM & 1)) {
            pg8::Gemm gm{ha, DM, wl + LW_IN, G.M, ZW, DM}; SOA.init(G.M, Gsz, cid);
            const int nrep = (pb & 1) ? 2 : 1;
            for (int rep = 0; rep < nrep; ++rep) { pg8::EpiZ E{z, part2, rep < nrep - 1}; pg8::gemm_phase(lds, gm, SOA, E); }
        } else if (ph == 1 && (PHM & 2)) {
            const int nblk = G.S / 128, lgb = (G.S == 4096) ? 5 : 6, nA = G.B * nblk * 2;
            const float* sink = args.in[6] + layer * 8;
            if (pb & 2) for (int u = cid; u < nA; u += Gsz) { const int g = u & 1, nb = (u >> 1) & (nblk - 1), b = (u >> 1) >> lgb; attn_unit(lds, z, Gb, 1024, rope, sink, G.S, b, nb, g); }
            if (PHM & 64) for (int u = cid; u < nA; u += Gsz) { const int g = u & 1, nb = (u >> 1) & (nblk - 1), b = (u >> 1) >> lgb; attn_unit(lds, z, z, ZW, rope, sink, G.S, b, nb, g); }
            const int nF = G.B * 128;
            const h16* t1a = (const h16*)(ws + WS_T1A);
            const int nrep = (pb & 4) ? 2 : 1;
            if (G.N1 == 64 && (PHM & 128)) { const f32x2* tw = (const f32x2*)(ws + WS_TW64); f1_load_table<64>(lds, (const h16*)(ws + WS_T1B64));
                for (int rep = 0; rep < nrep; ++rep) for (int u = cid; u < nF; u += Gsz) f1_unit<64>(lds, z, Gb, t1a, tw, G.S, u >> 7, (u >> 1) & 63, u & 1); }
            else if (PHM & 2048) { const f32x2* tw = (const f32x2*)(ws + WS_TW128); f1_load_table<128>(lds, (const h16*)(ws + WS_T1B128));
                for (int rep = 0; rep < nrep; ++rep) for (int u = cid; u < nF; u += Gsz) f1_unit<128>(lds, z, Gb, t1a, tw, G.S, u >> 7, (u >> 1) & 63, u & 1); }
        } else if (ph == 2 && (PHM & 4)) {
            convert_p(G, layer, p16);
            const h16* t2 = (const h16*)(ws + WS_T2);
            int tid_ = threadIdx.x; asm volatile("" : "+v"(tid_));
            const int lane = tid_ & 63, wid = tid_ >> 6, kb2 = wid & 1;
            h16x8 bt2[8];
#pragma unroll
            for (int kk = 0; kk < 8; ++kk) bt2[kk] = ld8(t2 + (size_t)(kb2 * 32 + (lane & 31)) * 128 + (kk >> 2) * 64 + 16 * (kk & 3) + 8 * (lane >> 5));
            const int nU = G.B * G.N1;
            const int nrep = (pb & 8) ? 2 : 1;
            for (int rep = 0; rep < nrep; ++rep)
            for (int u = cid; u < nU; u += Gsz) f2_unit(lds, z, Gb, wl + LW_FM, bt2, G.S, G.N1, u >> (G.N1 == 64 ? 6 : 7), u & (G.N1 - 1));
        } else if (ph == 3 && (PHM & 8)) {
            SO.init(G.M, Gsz, cid);
            const int nrep = (pb & 16) ? 2 : 1;
            for (int rep = 0; rep < nrep; ++rep) { const bool dry = rep < nrep - 1;
            { pg8::Gemm gm{z + C_Q, ZW, wl + LW_AO, G.M, DM, 512}; pg8::EpiD1 E{z, dry}; pg8::gemm_phase(lds, gm, SO, E); }
            { pg8::Gemm gm{z + C_UF, ZW, wl + LW_FO, G.M, DM, 512}; pg8::EpiD2 E{z, dry}; pg8::gemm_phase(lds, gm, SO, E); } }
        } else if (ph == 4 && (PHM & 16)) {
            SO.init(G.M, Gsz, cid);
            const int nrep = (pb & 32) ? 2 : 1;
            for (int rep = 0; rep < nrep; ++rep) {
            pg8::Gemm gm{z + C_MGA, ZW, wl + LW_OUT, G.M, DM, DM}; pg8::EpiE E{ha, z, part1, rep < nrep - 1}; pg8::gemm_phase(lds, gm, SO, E); }
        } else if (ph == 5 && (PHM & 32)) {
            SO.init(G.M, Gsz, cid);
            const int nrep = (pb & 64) ? 2 : 1;
            for (int rep = 0; rep < nrep; ++rep) { const bool dry = rep < nrep - 1;
            { pg8::Gemm gm{z + C_MGF, ZW, wl + LW_PG, G.M, DM, DM}; pg8::EpiF1 E{z, part1, dry}; pg8::gemm_phase(lds, gm, SO, E); }
            { pg8::Gemm gm{p16, PLE, wl + LW_PE, G.M, DM, PLE}; pg8::EpiF2 E{z, ha, part2, dry}; pg8::gemm_phase(lds, gm, SO, E); } }
        }
    }
}

extern "C" void kernel_launch(void* const* d_in, const int* in_sizes, int n_in, void* d_out, int out_size, void* d_ws, size_t ws_size, hipStream_t stream) {
    static int grid = 0;
    if (grid == 0) {
        if (n_in != 15 || ws_size < WS_END) { fprintf(stderr, "kernel_launch: need 15 inputs and %zu bytes of workspace (got %d, %zu)\n", (size_t)WS_END, n_in, ws_size); grid = -1; return; }
        int dev = 0, cus = 0, per_cu = 0;
        (void)hipGetDevice(&dev); (void)hipDeviceGetAttribute(&cus, hipDeviceAttributeMultiprocessorCount, dev);
        if (hipFuncSetAttribute((const void*)fwd_megakernel, hipFuncAttributeMaxDynamicSharedMemorySize, LDS_BYTES) != hipSuccess) { fprintf(stderr, "kernel_launch: hipFuncSetAttribute failed\n"); grid = -1; return; }
        if (hipOccupancyMaxActiveBlocksPerMultiprocessor(&per_cu, (const void*)fwd_megakernel, 512, LDS_BYTES) != hipSuccess || per_cu < 1) { fprintf(stderr, "kernel_launch: occupancy query says %d\n", per_cu); per_cu = 1; }
        (void)hipGetLastError();
        if (cus < GRID) { fprintf(stderr, "kernel_launch: built for %d CUs, device has %d\n", GRID, cus); grid = -1; return; }
        grid = GRID;
    }
    if (grid < 0) return;
    Args a{};
    for (int i = 0; i < 15; ++i) a.in[i] = (const float*)d_in[i];
    a.out = (float*)d_out; a.ws = (unsigned char*)d_ws; a.step_lo = 0; a.step_hi = N_STEPS; a.probe = PROBE_MASK;
    if (hipMemsetAsync((char*)d_ws + WS_BAR, 0, WS_BAR_BYTES, stream) != hipSuccess) { fprintf(stderr, "kernel_launch: memset failed\n"); return; }
    void* kargs[] = {&a};
    hipError_t e = hipLaunchCooperativeKernel((const void*)fwd_megakernel, dim3(grid), dim3(512), kargs, LDS_BYTES, stream);
    if (e != hipSuccess) fprintf(stderr, "kernel_launch: cooperative launch failed: %s (grid %d)\n", hipGetErrorString(e), grid);
}
```
